# Optimizing an MI355X kernel written in HIP

```python
import math
import jax, jax.numpy as jnp
from jax import lax
import numpy as np

D_MODEL = 1024
BATCH = 8
SEQ = 2048
DEPTH = 4
DEC_BATCH = 128
DEC_SEQ = 1
PAST_LEN = 16384
PAGE_SIZE = 128

MIX_DIM = D_MODEL
DN_DIM = MIX_DIM // 2
POOL_DIM = MIX_DIM - DN_DIM
DN_HEADS = 4
DN_HEAD_DIM = DN_DIM // DN_HEADS
QKV_DIM = 3 * DN_DIM
CONV_W = 4
CHUNK = 64
POOL_WINDOWS = (2, 4, 8, 16)
POOL_GROUPS = len(POOL_WINDOWS)
POOL_GROUP_DIM = POOL_DIM // POOL_GROUPS
POOL_BUF = max(POOL_WINDOWS) - 1
D_FF = 2816
IN_DIM = QKV_DIM + DN_DIM + 2 * DN_HEADS + POOL_DIM
DN_ALPHA = (2.0 * DEPTH) ** 0.25
DN_BETA = (8.0 * DEPTH) ** -0.25
LN_EPS = 1e-5
RMS_EPS = 1e-6
L2_EPS = 1e-6

kernel_name = "hymba_gdn_pool_macaron_deepnorm_step"


def layer_norm(x, g, b):
    xf = x.astype(jnp.float32)
    mu = jnp.mean(xf, axis=-1, keepdims=True)
    xc = xf - mu
    var = jnp.mean(xc * xc, axis=-1, keepdims=True)
    return (xc * lax.rsqrt(var + LN_EPS) * g.astype(jnp.float32) + b.astype(jnp.float32)).astype(x.dtype)


def swiglu(x, wg, wu, wd):
    return (jax.nn.silu(x @ wg) * (x @ wu)) @ wd


def l2norm(x):
    return x * lax.rsqrt(jnp.sum(x * x, axis=-1, keepdims=True) + L2_EPS)


def causal_conv(xin, buf, w):
    L = xin.shape[1]
    ext = jnp.concatenate([buf.astype(xin.dtype), xin], axis=1)
    out = sum(w[i] * ext[:, i:i + L] for i in range(CONV_W))
    return jax.nn.silu(out), ext[:, -(CONV_W - 1):]


def gated_delta_chunked(q, k, v, beta, g, s0, chunk):
    B, L, H, DK = q.shape
    DV = v.shape[-1]
    N = L // chunk

    def blk(t):
        t = t.reshape((B, N, chunk, H) + t.shape[3:])
        return jnp.moveaxis(t, (1, 3), (0, 2))

    qb, kb, vb, bb, gb = blk(q), blk(k), blk(v), blk(beta), blk(g)
    gc = jnp.cumsum(gb, axis=-1)
    idx = jnp.arange(chunk)
    incl = idx[:, None] >= idx[None, :]
    strict = idx[:, None] > idx[None, :]
    diff = gc[..., :, None] - gc[..., None, :]
    dec = jnp.where(incl, jnp.exp(jnp.where(incl, diff, 0.0)), 0.0)
    kk = jnp.einsum('nbhcd,nbhsd->nbhcs', kb, kb)
    m = jnp.where(strict, bb[..., :, None] * kk * dec, 0.0)
    a_mat = jnp.eye(chunk, dtype=jnp.float32) + m
    rhs = jnp.concatenate([bb[..., None] * vb, (bb * jnp.exp(gc))[..., None] * kb], axis=-1)
    sol = lax.linalg.triangular_solve(a_mat, rhs, left_side=True, lower=True, unit_diagonal=True)
    uv, wk = sol[..., :DV], sol[..., DV:]
    qk = jnp.einsum('nbhcd,nbhsd->nbhcs', qb, kb) * dec
    q_dec = qb * jnp.exp(gc)[..., None]
    k_end = kb * jnp.exp(gc[..., -1:] - gc)[..., None]
    g_end = jnp.exp(gc[..., -1])

    def step(s, xs):
        uv_c, w_c, qk_c, qd_c, ke_c, ge_c = xs
        u = uv_c - jnp.einsum('bhcd,bhde->bhce', w_c, s)
        o = jnp.einsum('bhcd,bhde->bhce', qd_c, s) + jnp.einsum('bhcs,bhse->bhce', qk_c, u)
        s = ge_c[..., None, None] * s + jnp.einsum('bhcd,bhce->bhde', ke_c, u)
        return s, o

    s_fin, o = lax.scan(step, s0, (uv, wk, qk, q_dec, k_end, g_end))
    o = jnp.moveaxis(o, (0, 2), (1, 3)).reshape(B, L, H, DV)
    return o, s_fin


def pool_mix(p, buf, start_pos, pool_w, pool_scale):
    B, L, _ = p.shape
    ext = jnp.concatenate([buf.astype(jnp.float32), p.astype(jnp.float32)], axis=1)
    cs = jnp.concatenate([jnp.zeros((B, 1, POOL_DIM), jnp.float32), jnp.cumsum(ext, axis=1)], axis=1)
    end = cs[:, POOL_BUF + 1:]
    pos = start_pos + jnp.arange(L)
    means = []
    for gi, w in enumerate(POOL_WINDOWS):
        sl = slice(gi * POOL_GROUP_DIM, (gi + 1) * POOL_GROUP_DIM)
        s = end[:, :, sl] - cs[:, POOL_BUF + 1 - w:POOL_BUF + 1 - w + L, sl]
        cnt = jnp.minimum(w, pos + 1).astype(jnp.float32)
        means.append(s / cnt[None, :, None])
    d = jnp.concatenate(means, axis=-1) - ext[:, POOL_BUF:]
    d = d.reshape(B, L, POOL_GROUPS, POOL_GROUP_DIM).astype(p.dtype)
    y = jnp.einsum('blgc,gcd->blgd', d, pool_w).reshape(B, L, POOL_DIM) * pool_scale
    return y, ext[:, -POOL_BUF:].astype(p.dtype)


def mixer(h, s0, conv_buf, pool_buf, start_pos, chunk, w_in, conv_w, a_log, dt_bias, onorm_g, pool_w, pool_scale, w_out):
    B, L, _ = h.shape
    proj = h @ w_in
    qkv, z, b_raw, a_raw, p = jnp.split(
        proj, [QKV_DIM, QKV_DIM + DN_DIM, QKV_DIM + DN_DIM + DN_HEADS, QKV_DIM + DN_DIM + 2 * DN_HEADS], axis=-1)
    qkv_c, new_conv = causal_conv(qkv, conv_buf, conv_w)
    q, k, v = jnp.split(qkv_c.astype(jnp.float32), 3, axis=-1)
    q = l2norm(q.reshape(B, L, DN_HEADS, DN_HEAD_DIM)) * (DN_HEAD_DIM ** -0.5)
    k = l2norm(k.reshape(B, L, DN_HEADS, DN_HEAD_DIM))
    v = v.reshape(B, L, DN_HEADS, DN_HEAD_DIM)
    beta = jax.nn.sigmoid(b_raw.astype(jnp.float32))
    g = -jnp.exp(a_log.astype(jnp.float32)) * jax.nn.softplus(a_raw.astype(jnp.float32) + dt_bias.astype(jnp.float32))
    o, s_new = gated_delta_chunked(q, k, v, beta, g, s0.astype(jnp.float32), chunk)
    zf = z.astype(jnp.float32).reshape(B, L, DN_HEADS, DN_HEAD_DIM)
    o = o * lax.rsqrt(jnp.mean(o * o, axis=-1, keepdims=True) + RMS_EPS) * onorm_g.astype(jnp.float32) * jax.nn.silu(zf)
    o_dn = o.reshape(B, L, DN_DIM).astype(h.dtype)
    o_pool, new_pool = pool_mix(p, pool_buf, start_pos, pool_w, pool_scale)
    out = jnp.concatenate([o_dn, o_pool], axis=-1) @ w_out
    return out, s_new.astype(s0.dtype), new_conv.astype(conv_buf.dtype), new_pool.astype(pool_buf.dtype)


def layer(x, s0, conv_buf, pool_buf, start_pos, chunk, ln1_g, ln1_b, f1g, f1u, f1d, w_in, conv_w, a_log, dt_bias,
          onorm_g, pool_w, pool_scale, w_out, ln2_g, ln2_b, f2g, f2u, f2d, ln3_g, ln3_b):
    h = layer_norm(DN_ALPHA * x + 0.5 * swiglu(x, f1g, f1u, f1d), ln1_g, ln1_b)
    mix, s_new, c_new, p_new = mixer(h, s0, conv_buf, pool_buf, start_pos, chunk, w_in, conv_w, a_log, dt_bias,
                                     onorm_g, pool_w, pool_scale, w_out)
    h = layer_norm(DN_ALPHA * h + mix, ln2_g, ln2_b)
    y = layer_norm(DN_ALPHA * h + 0.5 * swiglu(h, f2g, f2u, f2d), ln3_g, ln3_b)
    return y, s_new, c_new, p_new


def setup_inputs(seed: int = 0) -> dict:
    key = jax.random.key(seed)
    ks = iter(jax.random.split(key, 40))
    f32 = jnp.float32
    nrm = lambda shape, scale: jax.random.normal(next(ks), shape, f32) * scale
    inp = {}
    inp['x_prompt'] = nrm((BATCH, SEQ, D_MODEL), 1.0)
    inp['x_sample'] = nrm((DEC_BATCH, DEC_SEQ, D_MODEL), 1.0)
    inp['state_delta'] = nrm((DEPTH, DEC_BATCH, DN_HEADS, DN_HEAD_DIM, DN_HEAD_DIM), 0.05)
    inp['state_conv'] = nrm((DEPTH, DEC_BATCH, CONV_W - 1, QKV_DIM), 1.0)
    inp['state_pool'] = nrm((DEPTH, DEC_BATCH, POOL_BUF, POOL_DIM), 1.0)
    inp['ln1_g'] = 1.0 + nrm((DEPTH, D_MODEL), 0.02)
    inp['ln1_b'] = nrm((DEPTH, D_MODEL), 0.02)
    inp['ffn1_w_gate'] = nrm((DEPTH, D_MODEL, D_FF), D_MODEL ** -0.5)
    inp['ffn1_w_up'] = nrm((DEPTH, D_MODEL, D_FF), D_MODEL ** -0.5)
    inp['ffn1_w_down'] = nrm((DEPTH, D_FF, D_MODEL), DN_BETA * D_FF ** -0.5)
    inp['w_in'] = nrm((DEPTH, D_MODEL, IN_DIM), D_MODEL ** -0.5)
    inp['conv_w'] = nrm((DEPTH, CONV_W, QKV_DIM), CONV_W ** -0.5)
    inp['a_log'] = jnp.log(jax.random.uniform(next(ks), (DEPTH, DN_HEADS), f32, 1.0, 16.0))
    dt = jnp.exp(jax.random.uniform(next(ks), (DEPTH, DN_HEADS), f32, math.log(1e-3), math.log(1e-1)))
    inp['dt_bias'] = dt + jnp.log(-jnp.expm1(-dt))
    inp['onorm_g'] = 1.0 + nrm((DEPTH, DN_HEAD_DIM), 0.02)
    inp['pool_w'] = nrm((DEPTH, POOL_GROUPS, POOL_GROUP_DIM, POOL_GROUP_DIM), POOL_GROUP_DIM ** -0.5)
    inp['pool_scale'] = 1.0 + nrm((DEPTH, POOL_DIM), 0.05)
    inp['w_out'] = nrm((DEPTH, MIX_DIM, D_MODEL), DN_BETA * MIX_DIM ** -0.5)
    inp['ln2_g'] = 1.0 + nrm((DEPTH, D_MODEL), 0.02)
    inp['ln2_b'] = nrm((DEPTH, D_MODEL), 0.02)
    inp['ffn2_w_gate'] = nrm((DEPTH, D_MODEL, D_FF), D_MODEL ** -0.5)
    inp['ffn2_w_up'] = nrm((DEPTH, D_MODEL, D_FF), D_MODEL ** -0.5)
    inp['ffn2_w_down'] = nrm((DEPTH, D_FF, D_MODEL), DN_BETA * D_FF ** -0.5)
    inp['ln3_g'] = 1.0 + nrm((DEPTH, D_MODEL), 0.02)
    inp['ln3_b'] = nrm((DEPTH, D_MODEL), 0.02)
    return inp


def reference(x_prompt, x_sample, state_delta, state_conv, state_pool, ln1_g, ln1_b, ffn1_w_gate, ffn1_w_up,
              ffn1_w_down, w_in, conv_w, a_log, dt_bias, onorm_g, pool_w, pool_scale, w_out, ln2_g, ln2_b,
              ffn2_w_gate, ffn2_w_up, ffn2_w_down, ln3_g, ln3_b):
    dt = x_prompt.dtype
    chunk_prompt = math.gcd(SEQ, CHUNK)
    chunk_sample = math.gcd(DEC_SEQ, CHUNK)
    xp, xs = x_prompt, x_sample
    dp, cp, pp, ds, cs_, ps = [], [], [], [], [], []
    for l in range(DEPTH):
        w = (ln1_g[l], ln1_b[l], ffn1_w_gate[l], ffn1_w_up[l], ffn1_w_down[l], w_in[l], conv_w[l], a_log[l],
             dt_bias[l], onorm_g[l], pool_w[l], pool_scale[l], w_out[l], ln2_g[l], ln2_b[l], ffn2_w_gate[l],
             ffn2_w_up[l], ffn2_w_down[l], ln3_g[l], ln3_b[l])
        s0 = jnp.zeros((BATCH, DN_HEADS, DN_HEAD_DIM, DN_HEAD_DIM), dt)
        c0 = jnp.zeros((BATCH, CONV_W - 1, QKV_DIM), dt)
        p0 = jnp.zeros((BATCH, POOL_BUF, POOL_DIM), dt)
        xp, s_p, c_p, p_p = layer(xp, s0, c0, p0, 0, chunk_prompt, *w)
        xs, s_s, c_s, p_s = layer(xs, state_delta[l], state_conv[l], state_pool[l], PAST_LEN, chunk_sample, *w)
        dp.append(s_p); cp.append(c_p); pp.append(p_p)
        ds.append(s_s); cs_.append(c_s); ps.append(p_s)
    delta_prompt = jnp.stack(dp)
    conv_prompt = jnp.stack(cp)
    pool_prompt = jnp.stack(pp)
    delta_sample = jnp.stack(ds)
    conv_sample = jnp.stack(cs_)
    pool_sample = jnp.stack(ps)
    return (xp, xs, delta_prompt, conv_prompt, pool_prompt, delta_sample, conv_sample, pool_sample)
```

```cpp
#include <hip/hip_runtime.h>
#include <hip/hip_cooperative_groups.h>
#include <cstdio>
namespace cg = cooperative_groups;

#ifndef MK_MULTI
#define MK_MULTI 0
#endif

#ifndef PHMASK
#define PHMASK 0xFFFF
#endif
#define PHON(i) ((PHMASK >> (i)) & 1)
#define LAS __attribute__((address_space(3)))
typedef unsigned short bf16_t;
typedef short bf16x8 __attribute__((ext_vector_type(8)));
typedef float f32x4 __attribute__((ext_vector_type(4)));
typedef float f32x2 __attribute__((ext_vector_type(2)));
typedef unsigned u32x4 __attribute__((ext_vector_type(4)));
typedef unsigned u32x2 __attribute__((ext_vector_type(2)));
typedef __bf16 nbf2 __attribute__((ext_vector_type(2)));
#define DI __device__ __forceinline__

constexpr int DM = 1024, FF = 2816, NPROMPT = 16384, NSAMP = 128, NVALID = 16512, ROWS = 16640, DEPTH = 4;
constexpr int NPROJ = 2560, INDIM = 2568, QKVD = 1536;
constexpr float ALPHA = 1.681792830507429f;
constexpr int LDS_MAIN = 139264, LDS_BYTES = LDS_MAIN + 16;
constexpr int NPH = 1 + 12 * DEPTH;

constexpr size_t SZ_GU = (size_t)5632 * 1024 * 2, SZ_D = (size_t)1024 * 2816 * 2, SZ_WIN = (size_t)2560 * 1024 * 2, SZ_WOUT = (size_t)1024 * 1024 * 2, SZ_PW = (size_t)4 * 128 * 128 * 2;
constexpr size_t WO_GU1 = 0, WO_D1 = WO_GU1 + SZ_GU, WO_WIN = WO_D1 + SZ_D, WO_WOUT = WO_WIN + SZ_WIN, WO_GU2 = WO_WOUT + SZ_WOUT, WO_D2 = WO_GU2 + SZ_GU, WO_PW = WO_D2 + SZ_D, W_LSTRIDE = WO_PW + SZ_PW;
constexpr size_t WS_W = 0;
constexpr size_t WS_R = WS_W + DEPTH * W_LSTRIDE;
constexpr size_t WS_XB = WS_R + (size_t)ROWS * DM * 4;
constexpr size_t WS_HID = WS_XB + (size_t)ROWS * DM * 2;
constexpr size_t WS_MIX = WS_HID + (size_t)ROWS * FF * 2;
constexpr size_t WS_O = WS_MIX + (size_t)ROWS * DM * 2;
constexpr size_t WS_BETA = WS_O + (size_t)ROWS * 512 * 4;
constexpr size_t WS_G = WS_BETA + (size_t)ROWS * 16;
constexpr size_t WS_UV = WS_G + (size_t)ROWS * 16;
constexpr size_t WS_WK = WS_UV + (size_t)1024 * 8192 * 4;
constexpr size_t WS_QD = WS_WK + (size_t)1024 * 8192 * 2;
constexpr size_t WS_KET = WS_QD + (size_t)1024 * 8192 * 2;
constexpr size_t WS_QK = WS_KET + (size_t)1024 * 8192 * 2;
constexpr size_t WS_GE = WS_QK + (size_t)1024 * 4096 * 2;
constexpr size_t WS_BAR = WS_GE + 4096;
constexpr size_t WS_PART = WS_BAR + 16384;
constexpr size_t WS_END = WS_PART + (size_t)11 * 256 * 1024 * 4;

constexpr size_t OUT_YP = 0, OUT_YS = 16777216, OUT_DP = 16908288, OUT_CP = 19005440, OUT_PP = 19152896, OUT_DS = 19398656, OUT_CS = 52953088, OUT_PS = 55312384;

struct Args { const float* in[25]; float* out; unsigned char* ws; int ph_lo, ph_hi; };

DI const float* INP(const Args& a, int i) { asm volatile("" : "+s"(i)); return a.in[i]; }
DI unsigned pk2(float a, float b) { f32x2 v = {a, b}; nbf2 r = __builtin_convertvector(v, nbf2); return __builtin_bit_cast(unsigned, r); }
DI bf16_t f2bf(float a) { return (bf16_t)(pk2(a, 0.f) & 0xffffu); }
DI float bflo(unsigned w) { return __uint_as_float(w << 16); }
DI float bfhi(unsigned w) { return __uint_as_float(w & 0xffff0000u); }
DI float bf2f(bf16_t b) { return __uint_as_float(((unsigned)b) << 16); }
DI float silu_f(float x) { return x * __builtin_amdgcn_rcpf(1.f + __expf(-x)); }
DI float wave_sum(float v) {
#pragma unroll
    for (int o = 32; o > 0; o >>= 1) v += __shfl_xor(v, o);
    return v;
}
DI bf16x8 pack8(const f32x4& a, const f32x4& b) { u32x4 p; p.x = pk2(a[0], a[1]); p.y = pk2(a[2], a[3]); p.z = pk2(b[0], b[1]); p.w = pk2(b[2], b[3]); return __builtin_bit_cast(bf16x8, p); }
DI int perm6(int j) { return (j & 32) | (((j >> 2) & 3) << 3) | (((j >> 4) & 1) << 2) | (j & 3); }
DI int perm7(int j) { return (j & 96) | (((j >> 2) & 3) << 3) | (((j >> 4) & 1) << 2) | (j & 3); }
#define MFMA16(a, b, c) __builtin_amdgcn_mfma_f32_16x16x32_bf16((a), (b), (c), 0, 0, 0)


#define XB_TMO      128
#define XB_XCNT(j)  (256  + 64 * (j))
#define XB_XSUB(j)  (1280 + 64 * (j))
#define XB_XGEN(j)  (2304 + 64 * (j))
#define XB_TOP      3328
#define XB_TOPGEN   3392
#define XCD_BAR_WORDS 3456
#define XB_SPIN_CAP (1u << 22)
DI unsigned xb_ld(unsigned* p)              { return __hip_atomic_load(p, __ATOMIC_RELAXED, __HIP_MEMORY_SCOPE_AGENT); }
DI unsigned xb_add(unsigned* p, unsigned v) { return __hip_atomic_fetch_add(p, v, __ATOMIC_RELAXED, __HIP_MEMORY_SCOPE_AGENT); }
DI unsigned xb_xcc_id() { return (unsigned)__builtin_amdgcn_s_getreg((3 << 11) | 20) & 0xFu; }
#define XB_SPIN(cond, bar) do { unsigned _sp = 0; while (cond) { __builtin_amdgcn_s_sleep(1); \
    if ((++_sp & 255u) == 0u) { if (xb_ld(&(bar)[XB_TMO])) break; if (_sp > XB_SPIN_CAP) { atomicAdd(&(bar)[XB_TMO], 1u); break; } } } } while (0)
struct XcdBarrier { unsigned* bar; unsigned x; volatile LAS unsigned* st; };
DI XcdBarrier xcd_barrier_post(unsigned* bar, volatile LAS unsigned* st) {
    XcdBarrier b; b.bar = bar; b.x = xb_xcc_id(); b.st = st;
    if (threadIdx.x == 0) (void)xb_add(&bar[XB_XCNT(b.x)], 1u);
    return b;
}
DI void xcd_barrier_complete(unsigned* bar, unsigned x, unsigned& nloc, unsigned& nx) {
    const unsigned G = gridDim.x * gridDim.y * gridDim.z;
    unsigned sum, cnt, mine, sp = 0u;
    for (;;) {
        sum = 0u; cnt = 0u; mine = 0u;
#pragma unroll
        for (unsigned j = 0; j < 16; ++j) { const unsigned c = xb_ld(&bar[XB_XCNT(j)]); sum += c; cnt += (c > 0u) ? 1u : 0u; mine = (j == x) ? c : mine; }
        if (sum == G) break;
        __builtin_amdgcn_s_sleep(1);
        if ((++sp & 255u) == 0u) { if (xb_ld(&bar[XB_TMO])) break; if (sp > XB_SPIN_CAP) { atomicAdd(&bar[XB_TMO], 1u); break; } }
    }
    nloc = mine > 0u ? mine : 1u; nx = cnt > 0u ? cnt : 1u;
}
DI void xcd_barrier(const XcdBarrier& b) {
    asm volatile("s_waitcnt vmcnt(0)" ::: "memory");
    __syncthreads();
    if (threadIdx.x == 0) {
        unsigned* bar = b.bar;
        __builtin_amdgcn_s_waitcnt(0);
        unsigned nloc = b.st[0], nx = b.st[1];
        if (nloc == 0u) { xcd_barrier_complete(bar, b.x, nloc, nx); b.st[0] = nloc; b.st[1] = nx; }
        const unsigned old = xb_add(&bar[XB_XSUB(b.x)], 1u);
        const unsigned gen = old / nloc;
        if (old + 1u == (gen + 1u) * nloc) {
            __builtin_amdgcn_fence(__ATOMIC_RELEASE, "agent");
            asm volatile("s_waitcnt vmcnt(0)" ::: "memory");
            const unsigned og = xb_add(&bar[XB_TOP], 1u);
            const unsigned tg = og / nx;
            if (og + 1u == (tg + 1u) * nx) xb_add(&bar[XB_TOPGEN], 1u);
            else XB_SPIN(xb_ld(&bar[XB_TOPGEN]) == tg, bar);
            __builtin_amdgcn_fence(__ATOMIC_ACQUIRE, "agent");
            xb_add(&bar[XB_XGEN(b.x)], 1u);
            asm volatile("s_waitcnt vmcnt(0)" ::: "memory");
        } else {
            XB_SPIN(xb_ld(&bar[XB_XGEN(b.x)]) == gen, bar);
            __builtin_amdgcn_fence(__ATOMIC_ACQUIRE, "agent");
            asm volatile("s_waitcnt vmcnt(0)" ::: "memory");
        }
    }
    __syncthreads();
}

namespace pg8 {
constexpr int BM = 256, BK = 64, HALF = 128, HTB = HALF * BK * 2, STAGE_BYTES = 8 * HTB, NXCD = 8, WGM = 8;
DI int lds_byte(int r, int c) { const int st = (r >> 4) * 2 + (c >> 5), rr = r & 15, cc = c & 31, ob = rr * 64 + cc * 2; return st * 1024 + (ob ^ (((ob >> 9) & 1) << 5)); }
DI void stage_rc(int b, int& R, int& C) { const int st = b / 1024, sb = b % 1024, swz = sb ^ (((sb >> 9) & 1) << 5); R = (st >> 1) * 16 + swz / 64; C = (st & 1) * 32 + (swz % 64) / 2; }
struct Unit { int pm, pn, kt0, nt, split; };
struct Gemm { const bf16_t* A; const bf16_t* Bt; int M, N, K; };
struct StaticOrder {
    int nM, nN, nwg, G, c, ntFull, ntSplit, ntot;
    DI void init(int M, int N, int K, int G_, int c_, int parts) { nM = M / BM; nN = N / BM; nwg = nM * nN; G = G_; c = c_; ntFull = K / BK; ntSplit = parts > 0 ? ntFull / parts : ntFull; ntot = nwg + 4 * parts; }
    DI bool next(int i, Unit& u) const {
        const int L = i * G + c;
        if (L >= ntot) return false;
        const bool sp = L >= nwg;
        int wgid = sp ? 0 : L; { const int q = nwg / NXCD, r = nwg % NXCD, xcd = wgid % NXCD, off = wgid / NXCD; wgid = (xcd < r ? xcd * (q + 1) : r * (q + 1) + (xcd - r) * q) + off; }
        const int nig = WGM * nN, gid = wgid / nig, fm = gid * WGM, gsz = (nM - fm) < WGM ? (nM - fm) : WGM;
        const int pm_s = fm + ((wgid % nig) % gsz), pn_s = (wgid % nig) / gsz;
        const int j = sp ? L - nwg : 0;
        u.pm = sp ? nM : pm_s; u.pn = sp ? (j & 3) : pn_s; u.kt0 = sp ? (j >> 2) * ntSplit : 0; u.nt = sp ? ntSplit : ntFull; u.split = sp ? 1 : 0;
        return true;
    }
};

template <class Epi, class Sched>
DI void gemm_phase(LAS unsigned char* lds, const Gemm g, const Sched& S, const Epi& E) {
    int tid_ = threadIdx.x; asm volatile("" : "+v"(tid_));
    const int tid = tid_, wid = __builtin_amdgcn_readfirstlane(tid >> 6), lane = tid & 63, wr = wid >> 2, wc = wid & 3, fr = lane & 15, fq = lane >> 4;
    const int K = g.K;
    unsigned voffA[2], voffB[2];
#pragma unroll
    for (int i = 0; i < 2; ++i) { int R, C; stage_rc(tid * 16 + i * 8192, R, C); voffA[i] = (unsigned)(R * K + C) * 2u; voffB[i] = voffA[i]; }
    const size_t kstep = (size_t)(BK * 2);
    const size_t hstep = (size_t)HALF * K * 2;
    const size_t tstep = 2 * hstep;
    const unsigned ldsw = (unsigned)wid * 1024u;
    const int aoff = lds_byte(wr * 64 + fr, fq * 8), boff = lds_byte(wc * 32 + fr, fq * 8);
#define PG8_SA(b, h) (((b) * 2 + (h)) * HTB)
#define PG8_SB(b, h) ((4 + (b) * 2 + (h)) * HTB)
#define PG8_STAGE(bufoff, gbase, voff) do { _Pragma("unroll") for (int _i = 0; _i < 2; ++_i) \
        __builtin_amdgcn_global_load_lds((const unsigned*)((const char*)(gbase) + (voff)[_i]), (LAS unsigned*)(lds + (bufoff) + ldsw + _i * 8192), 16, 0, 0); } while (0)
#define PG8_LDA(dst, b, h) do { _Pragma("unroll") for (int m = 0; m < 4; ++m) _Pragma("unroll") for (int k = 0; k < 2; ++k) dst[m][k] = *(const LAS bf16x8*)(lds + PG8_SA(b, h) + aoff + m * 2048 + k * 1024); } while (0)
#define PG8_LDB(dst, b, h) do { _Pragma("unroll") for (int n = 0; n < 2; ++n) _Pragma("unroll") for (int k = 0; k < 2; ++k) dst[n][k] = *(const LAS bf16x8*)(lds + PG8_SB(b, h) + boff + n * 2048 + k * 1024); } while (0)
#define PG8_MMA(ai, bj, At, Bt) do { __builtin_amdgcn_s_setprio(1); _Pragma("unroll") for (int m = 0; m < 4; ++m) _Pragma("unroll") for (int n = 0; n < 2; ++n) _Pragma("unroll") for (int k = 0; k < 2; ++k) \
        acc[ai][bj][m][n] = __builtin_amdgcn_mfma_f32_16x16x32_bf16(Bt[n][k], At[m][k], acc[ai][bj][m][n], 0, 0, 0); __builtin_amdgcn_s_setprio(0); } while (0)
#define PG8_WAIT_V(n) asm volatile("s_waitcnt vmcnt(" #n ")" ::: "memory")
#define PG8_WAIT_L(n) asm volatile("s_waitcnt lgkmcnt(" #n ")" ::: "memory")
#define PG8_BAR __builtin_amdgcn_s_barrier()
#define PG8_SCHED __builtin_amdgcn_sched_barrier(0)
    Unit cur, nxt; int ui = 0;
    if (!S.next(0, cur)) return;
    f32x4 acc[2][2][4][2];
#pragma unroll
    for (int a = 0; a < 2; ++a)
#pragma unroll
        for (int b = 0; b < 2; ++b)
#pragma unroll
            for (int m = 0; m < 4; ++m)
#pragma unroll
                for (int n = 0; n < 2; ++n) acc[a][b][m][n] = (f32x4){0.f, 0.f, 0.f, 0.f};
    bf16x8 At[4][2], B0[2][2], B1[2][2];
    const char* cA = (const char*)g.A + (size_t)cur.pm * tstep + (size_t)cur.kt0 * kstep; const char* cB = (const char*)g.Bt + (size_t)cur.pn * tstep + (size_t)cur.kt0 * kstep;
    PG8_STAGE(PG8_SB(0, 0), cB, voffB); PG8_STAGE(PG8_SA(0, 0), cA, voffA); PG8_STAGE(PG8_SB(0, 1), cB + hstep, voffB); PG8_STAGE(PG8_SA(0, 1), cA + hstep, voffA);
    if (wr == 1) PG8_BAR;
    PG8_WAIT_V(4); PG8_BAR;
    PG8_STAGE(PG8_SB(1, 0), cB + kstep, voffB); PG8_STAGE(PG8_SA(1, 0), cA + kstep, voffA); PG8_STAGE(PG8_SB(1, 1), cB + hstep + kstep, voffB);
    PG8_WAIT_V(6); PG8_BAR;
    for (;;) {
        const bool has_next = S.next(ui + 1, nxt);
        const char* nA = has_next ? (const char*)g.A + (size_t)nxt.pm * tstep + (size_t)nxt.kt0 * kstep : cA; const char* nB = has_next ? (const char*)g.Bt + (size_t)nxt.pn * tstep + (size_t)nxt.kt0 * kstep : cB;
        const int nt = cur.nt;
        for (int t = 0; t < nt; t += 2) {
            const bool last = (t == nt - 2);
            const char* a1 = cA + (size_t)(t + 1) * kstep;
            const char* a2 = last ? nA : cA + (size_t)(t + 2) * kstep; const char* b2 = last ? nB : cB + (size_t)(t + 2) * kstep;
            const char* a3 = a2 + kstep; const char* b3 = b2 + kstep;
            PG8_LDB(B0, 0, 0); PG8_SCHED; PG8_LDA(At, 0, 0); PG8_STAGE(PG8_SA(1, 1), a1 + hstep, voffA);
            PG8_WAIT_L(8); PG8_BAR; PG8_WAIT_L(0); PG8_MMA(0, 0, At, B0); PG8_BAR; PG8_SCHED;
            PG8_LDB(B1, 0, 1); PG8_STAGE(PG8_SB(0, 0), b2, voffB);
            PG8_BAR; PG8_WAIT_L(0); PG8_MMA(0, 1, At, B1); PG8_BAR;
            PG8_LDA(At, 0, 1); PG8_STAGE(PG8_SA(0, 0), a2, voffA);
            PG8_BAR; PG8_WAIT_L(0); PG8_MMA(1, 0, At, B0); PG8_BAR; PG8_SCHED;
            PG8_STAGE(PG8_SB(0, 1), b2 + hstep, voffB);
            PG8_WAIT_V(6); PG8_BAR; PG8_MMA(1, 1, At, B1); PG8_BAR;
            PG8_LDB(B0, 1, 0); PG8_SCHED; PG8_LDA(At, 1, 0); PG8_STAGE(PG8_SA(0, 1), a2 + hstep, voffA);
            PG8_WAIT_L(8); PG8_BAR; PG8_WAIT_L(0); PG8_MMA(0, 0, At, B0); PG8_BAR; PG8_SCHED;
            PG8_LDB(B1, 1, 1); PG8_STAGE(PG8_SB(1, 0), b3, voffB);
            PG8_BAR; PG8_WAIT_L(0); PG8_MMA(0, 1, At, B1); PG8_BAR;
            PG8_LDA(At, 1, 1); PG8_STAGE(PG8_SA(1, 0), a3, voffA);
            PG8_BAR; PG8_WAIT_L(0); PG8_MMA(1, 0, At, B0); PG8_BAR; PG8_SCHED;
            PG8_STAGE(PG8_SB(1, 1), b3 + hstep, voffB);
            PG8_WAIT_V(6); PG8_BAR; PG8_MMA(1, 1, At, B1); PG8_BAR;
        }
        E(acc, cur, wr, wc, fr, fq);
        if (!has_next) break;
#pragma unroll
        for (int a = 0; a < 2; ++a)
#pragma unroll
            for (int b = 0; b < 2; ++b)
#pragma unroll
                for (int m = 0; m < 4; ++m)
#pragma unroll
                    for (int n = 0; n < 2; ++n) acc[a][b][m][n] = (f32x4){0.f, 0.f, 0.f, 0.f};
        cur = nxt; cA = nA; cB = nB; ++ui;
    }
    PG8_WAIT_V(0);
    if (wr == 0) PG8_BAR;
    PG8_BAR;
#undef PG8_SA
#undef PG8_SB
#undef PG8_STAGE
#undef PG8_LDA
#undef PG8_LDB
#undef PG8_MMA
#undef PG8_WAIT_V
#undef PG8_WAIT_L
#undef PG8_BAR
#undef PG8_SCHED
}
}

struct EpiResid {
    float* R; float* PART; float scale;
    DI void operator()(const f32x4 (&acc)[2][2][4][2], const pg8::Unit& u, int wr, int wc, int fr, int fq) const {
        const int row0 = u.pm * 256 + wr * 64 + fr, col0 = u.pn * 256 + wc * 32 + 4 * fq;
        const bf16_t* XBr = (const bf16_t*)((const unsigned char*)R + (WS_XB - WS_R));
        if (u.split) {
            float* P0 = PART + ((size_t)(u.kt0 / u.nt) * 256 + (wr * 64 + fr)) * DM + col0;
#pragma unroll
            for (int ai = 0; ai < 2; ++ai)
#pragma unroll
                for (int m = 0; m < 4; ++m) { float* rowp = P0 + (size_t)(ai * 128 + m * 16) * DM;
#pragma unroll
                    for (int bj = 0; bj < 2; ++bj)
#pragma unroll
                        for (int n = 0; n < 2; ++n) *(f32x4*)(rowp + bj * 128 + n * 16) = acc[ai][bj][m][n] * scale; }
            return; }
#pragma unroll
        for (int ai = 0; ai < 2; ++ai)
#pragma unroll
            for (int m = 0; m < 4; ++m) { float* rowp = R + (size_t)(row0 + ai * 128 + m * 16) * DM + col0;
#pragma unroll
                for (int bj = 0; bj < 2; ++bj)
#pragma unroll
                    for (int n = 0; n < 2; ++n) { const u32x2 hb = *(const u32x2*)(XBr + (size_t)(row0 + ai * 128 + m * 16) * DM + col0 + bj * 128 + n * 16);
                        const f32x4 r = (f32x4){bflo(hb.x), bfhi(hb.x), bflo(hb.y), bfhi(hb.y)} * ALPHA; *(f32x4*)(rowp + bj * 128 + n * 16) = r + acc[ai][bj][m][n] * scale; }
                if (m & 1) asm volatile("" ::: "memory"); }
    }
};
struct EpiSwiglu {
    bf16_t* H;
    DI void operator()(const f32x4 (&acc)[2][2][4][2], const pg8::Unit& u, int wr, int wc, int fr, int fq) const {
        const int row0 = u.pm * 256 + wr * 64 + fr, col0 = u.pn * 128 + wc * 32 + 8 * fq;
#pragma unroll
        for (int ai = 0; ai < 2; ++ai)
#pragma unroll
            for (int m = 0; m < 4; ++m) { bf16_t* rowp = H + (size_t)(row0 + ai * 128 + m * 16) * FF + col0;
                float h[8];
#pragma unroll
                for (int bj = 0; bj < 2; ++bj)
#pragma unroll
                    for (int j = 0; j < 4; j += 2) { const f32x2 g2 = {acc[ai][bj][m][0][j], acc[ai][bj][m][0][j + 1]}, u2 = {acc[ai][bj][m][1][j], acc[ai][bj][m][1][j + 1]};
                        const f32x2 t2 = g2 * (-1.4426950408889634f); f32x2 e2; e2[0] = __builtin_amdgcn_exp2f(t2[0]); e2[1] = __builtin_amdgcn_exp2f(t2[1]);
                        const f32x2 d2 = e2 + 1.0f; f32x2 r2; r2[0] = __builtin_amdgcn_rcpf(d2[0]); r2[1] = __builtin_amdgcn_rcpf(d2[1]);
                        const f32x2 h2 = (g2 * u2) * r2; h[bj * 4 + j] = h2[0]; h[bj * 4 + j + 1] = h2[1]; }
                u32x4 w; w.x = pk2(h[0], h[1]); w.y = pk2(h[2], h[3]); w.z = pk2(h[4], h[5]); w.w = pk2(h[6], h[7]);
                *(u32x4*)rowp = w; asm volatile("" ::: "memory"); }
    }
};
struct EpiProj {
    bf16_t* P; float* out; int layer;
    DI void operator()(const f32x4 (&acc)[2][2][4][2], const pg8::Unit& u, int wr, int wc, int fr, int fq) const {
        const int row0 = u.pm * 256 + wr * 64 + fr, colL = wc * 32 + 8 * fq;
        const bool special = ((u.pm & 7) == 7 || u.pm == 64) && (u.pn < 6 || u.pn >= 8);
#pragma unroll
        for (int ai = 0; ai < 2; ++ai)
#pragma unroll
            for (int m = 0; m < 4; ++m) { const int r = row0 + ai * 128 + m * 16;
#pragma unroll
                for (int bj = 0; bj < 2; ++bj) { const int pc = u.pn * 256 + bj * 128 + colL; const f32x4 v0 = acc[ai][bj][m][0], v1 = acc[ai][bj][m][1];
                    u32x4 w; w.x = pk2(v0[0], v0[1]); w.y = pk2(v0[2], v0[3]); w.z = pk2(v1[0], v1[1]); w.w = pk2(v1[2], v1[3]);
                    *(u32x4*)(P + (size_t)r * NPROJ + pc) = w;
                    if (special) { float* dst = nullptr;
                        if (r < NPROMPT) { const int tpos = r & 2047, b = r >> 11;
                            if (pc < QKVD) { if (tpos >= 2045) dst = out + OUT_CP + ((size_t)(layer * 8 + b) * 3 + (tpos - 2045)) * QKVD + pc; }
                            else if (pc >= 2048) { if (tpos >= 2033) dst = out + OUT_PP + ((size_t)(layer * 8 + b) * 15 + (tpos - 2033)) * 512 + (pc - 2048); } }
                        else if (r < NVALID) { const int b = r - NPROMPT;
                            if (pc < QKVD) dst = out + OUT_CS + ((size_t)(layer * 128 + b) * 3 + 2) * QKVD + pc;
                            else if (pc >= 2048) dst = out + OUT_PS + ((size_t)(layer * 128 + b) * 15 + 14) * 512 + (pc - 2048); }
                        if (dst) { *(f32x4*)dst = v0; *(f32x4*)(dst + 4) = v1; } } }
                asm volatile("" ::: "memory"); }
    }
};

DI void prep_phase(LAS unsigned char* lds, const Args& a) {
    LAS bf16_t* tile = (LAS bf16_t*)lds;
    LAS unsigned* t32 = (LAS unsigned*)lds;
    int tid_ = threadIdx.x; asm volatile("" : "+v"(tid_));
    const int tid = tid_, c = tid & 255, kh = tid >> 8;
    const int it_lo = (int)(((long)blockIdx.x * (DEPTH * 1280)) / gridDim.x), it_hi = (int)(((long)(blockIdx.x + 1) * (DEPTH * 1280)) / gridDim.x);
    for (int it = it_lo; it < it_hi; ++it) {
        const int l = it / 1280; int r = it % 1280;
        const float* src0; const float* src1 = nullptr; int Nsrc, K, pn, kt, kind; size_t dsto;
        if (r < 352) { kind = 0; pn = r / 16; kt = r % 16; src0 = INP(a, 7) + (size_t)l * DM * FF; src1 = INP(a, 8) + (size_t)l * DM * FF; Nsrc = FF; K = DM; dsto = WO_GU1; }
        else if (r < 704) { r -= 352; kind = 0; pn = r / 16; kt = r % 16; src0 = INP(a, 20) + (size_t)l * DM * FF; src1 = INP(a, 21) + (size_t)l * DM * FF; Nsrc = FF; K = DM; dsto = WO_GU2; }
        else if (r < 880) { r -= 704; kind = 1; pn = r / 44; kt = r % 44; src0 = INP(a, 9) + (size_t)l * FF * DM; Nsrc = DM; K = FF; dsto = WO_D1; }
        else if (r < 1056) { r -= 880; kind = 1; pn = r / 44; kt = r % 44; src0 = INP(a, 22) + (size_t)l * FF * DM; Nsrc = DM; K = FF; dsto = WO_D2; }
        else if (r < 1216) { r -= 1056; kind = 2; pn = r / 16; kt = r % 16; src0 = INP(a, 10) + (size_t)l * DM * INDIM; Nsrc = INDIM; K = DM; dsto = WO_WIN; }
        else { r -= 1216; kind = 1; pn = r / 16; kt = r % 16; src0 = INP(a, 17) + (size_t)l * DM * DM; Nsrc = DM; K = DM; dsto = WO_WOUT; }
        const int w8 = tid >> 6, c4 = (tid & 63) * 4;
        const float* sp; int ldsrow;
        if (kind == 0) { const int which = c4 >> 7, hc = c4 & 127; sp = (which ? src1 : src0) + pn * 128 + hc; ldsrow = 128 * ((hc >> 2) & 1) + 32 * (hc >> 5) + 16 * which + 4 * ((hc >> 3) & 3) + (hc & 3); }
        else if (kind == 1) { sp = src0 + pn * 256 + c4; ldsrow = c4; }
        else { const int pc = pn * 256 + c4; sp = src0 + (pc < 2048 ? pc : pc + 8); ldsrow = 128 * (c4 >> 7) + 32 * ((c4 >> 5) & 3) + 16 * ((c4 >> 2) & 1) + 4 * ((c4 >> 3) & 3) + (c4 & 3); }
        const int k0 = kt * 64;
        sp += (size_t)(k0 + w8) * Nsrc;
        f32x4 tv[8];
#pragma unroll
        for (int it = 0; it < 8; ++it) tv[it] = __builtin_nontemporal_load((const f32x4*)(sp + (size_t)(8 * it) * Nsrc));
#pragma unroll
        for (int it = 0; it < 8; ++it)
#pragma unroll
            for (int j = 0; j < 4; ++j) tile[(ldsrow + j) * 66 + w8 + 8 * it] = f2bf(tv[it][j]);
        __syncthreads();
        unsigned* d32 = (unsigned*)(a.ws + WS_W + (size_t)l * W_LSTRIDE + dsto) + ((size_t)(pn * 256) * K + k0) / 2;
#pragma unroll
        for (int j = 0; j < 16; ++j) { const int idx = j * 512 + tid, row = idx >> 5, dw = idx & 31; d32[(size_t)row * (K / 2) + dw] = t32[row * 33 + dw]; }
        __syncthreads();
    }
    const size_t gt = (size_t)blockIdx.x * 512 + tid, gs = (size_t)gridDim.x * 512;
    for (size_t i = gt; i < (size_t)DEPTH * 4 * 128 * 128; i += gs) { const int d = (int)(i & 127), cc = (int)((i >> 7) & 127); const size_t lg = i >> 14; const int l = (int)(lg >> 2), g = (int)(lg & 3);
        ((bf16_t*)(a.ws + WS_W + (size_t)l * W_LSTRIDE + WO_PW))[(size_t)(g * 128 + d) * 128 + cc] = f2bf(INP(a, 15)[i]); }
    { float* R = (float*)(a.ws + WS_R); bf16_t* XB = (bf16_t*)(a.ws + WS_XB);
      for (size_t i = gt; i < (size_t)ROWS * 256; i += gs) { const size_t row = i >> 8; const int c4 = (int)(i & 255) * 4; f32x4 v = {0.f, 0.f, 0.f, 0.f};
          if (row < NPROMPT) v = *(const f32x4*)(INP(a, 0) + row * DM + c4); else if (row < NVALID) v = *(const f32x4*)(INP(a, 1) + (row - NPROMPT) * DM + c4);
          *(f32x4*)(R + row * DM + c4) = v * ALPHA; u32x2 w; w.x = pk2(v[0], v[1]); w.y = pk2(v[2], v[3]); *(u32x2*)(XB + row * DM + c4) = w; } }
    for (size_t i = gt; i < (size_t)DEPTH * 128 * 2 * QKVD; i += gs) { const size_t lb = i / (2 * QKVD), rem = i % (2 * QKVD); a.out[OUT_CS + lb * 3 * QKVD + rem] = INP(a, 3)[lb * 3 * QKVD + QKVD + rem]; }
    for (size_t i = gt; i < (size_t)DEPTH * 128 * 14 * 512; i += gs) { const size_t lb = i / (14 * 512), rem = i % (14 * 512); a.out[OUT_PS + lb * 15 * 512 + rem] = INP(a, 4)[lb * 15 * 512 + 512 + rem]; }
}

DI void ln_phase(LAS unsigned char* lds, const Args& a, int l, int mode) {
    int tid_ = threadIdx.x; asm volatile("" : "+v"(tid_));
    const int tid = tid_, wave = tid >> 6, lane = tid & 63;
    float* R = (float*)(a.ws + WS_R); bf16_t* XB = (bf16_t*)(a.ws + WS_XB);
    const float* gam = INP(a, mode == 1 ? 5 : (mode == 2 ? 18 : 23)) + l * DM;
    const float* bet = INP(a, mode == 1 ? 6 : (mode == 2 ? 19 : 24)) + l * DM;
    LAS float* w8s = (LAS float*)lds;
    if (mode == 1) { const float* win = INP(a, 10) + (size_t)l * DM * INDIM + 2048;
        for (int i = tid; i < 8192; i += 512) { const int k = i >> 3, c = i & 7; w8s[c * 1024 + k] = win[(size_t)k * INDIM + c]; }
        __syncthreads(); }
    f32x4 g4[4], b4[4];
#pragma unroll
    for (int i = 0; i < 4; ++i) { g4[i] = *(const f32x4*)(gam + 256 * i + 4 * lane); b4[i] = *(const f32x4*)(bet + 256 * i + 4 * lane); }
    float alog = 0.f, dtb = 0.f;
    if (mode == 1) { alog = INP(a, 12)[l * 4 + (lane & 3)]; dtb = INP(a, 13)[l * 4 + (lane & 3)]; }
    const bool wy = (mode == 3 && l == DEPTH - 1);
    f32x4 xn[4];
    { const int row = blockIdx.x * 8 + wave; if (row < ROWS) {
#pragma unroll
        for (int i = 0; i < 4; ++i) xn[i] = *(const f32x4*)(R + (size_t)row * DM + 256 * i + 4 * lane); } }
    for (int row = blockIdx.x * 8 + wave; row < ROWS; row += gridDim.x * 8) {
        float* rp = R + (size_t)row * DM;
        f32x4 x[4];
#pragma unroll
        for (int i = 0; i < 4; ++i) x[i] = xn[i];
        { const int nrow = row + gridDim.x * 8; if (nrow < ROWS) {
#pragma unroll
            for (int i = 0; i < 4; ++i) xn[i] = *(const f32x4*)(R + (size_t)nrow * DM + 256 * i + 4 * lane); } }
        if (row >= NPROMPT) { const int np = (mode == 2) ? 4 : 11; const float* pp = (const float*)(a.ws + WS_PART) + (size_t)(row - NPROMPT) * DM + 4 * lane;
#pragma unroll
            for (int i = 0; i < 4; ++i) { const u32x2 hb = *(const u32x2*)(XB + (size_t)row * DM + 256 * i + 4 * lane); x[i] = (f32x4){bflo(hb.x), bfhi(hb.x), bflo(hb.y), bfhi(hb.y)} * ALPHA; }
            for (int p = 0; p < np; ++p) {
#pragma unroll
                for (int i = 0; i < 4; ++i) x[i] += *(const f32x4*)(pp + (size_t)p * 256 * DM + 256 * i); } }
        float s = 0.f;
#pragma unroll
        for (int i = 0; i < 4; ++i) s += (x[i][0] + x[i][1]) + (x[i][2] + x[i][3]);
        const float mean = wave_sum(s) * (1.f / 1024.f);
        float q = 0.f;
#pragma unroll
        for (int i = 0; i < 4; ++i) { x[i] = x[i] - mean; q += (x[i][0] * x[i][0] + x[i][1] * x[i][1]) + (x[i][2] * x[i][2] + x[i][3] * x[i][3]); }
        const float rstd = rsqrtf(wave_sum(q) * (1.f / 1024.f) + 1e-5f);
#pragma unroll
        for (int i = 0; i < 4; ++i) { x[i] = x[i] * rstd * g4[i] + b4[i];
            u32x2 w; w.x = pk2(x[i][0], x[i][1]); w.y = pk2(x[i][2], x[i][3]); *(u32x2*)(XB + (size_t)row * DM + 256 * i + 4 * lane) = w; }
        if (wy) { if (row < NPROMPT) { float* yp = a.out + OUT_YP + (size_t)row * DM;
#pragma unroll
                for (int i = 0; i < 4; ++i) *(f32x4*)(yp + 256 * i + 4 * lane) = x[i]; }
            else if (row < NVALID) { float* yp = a.out + OUT_YS + (size_t)(row - NPROMPT) * DM;
#pragma unroll
                for (int i = 0; i < 4; ++i) *(f32x4*)(yp + 256 * i + 4 * lane) = x[i]; } }
        if (mode == 1) {
            float d0 = 0.f, d1 = 0.f, d2 = 0.f, d3 = 0.f, d4 = 0.f, d5 = 0.f, d6 = 0.f, d7 = 0.f;
#pragma unroll
            for (int i = 0; i < 4; ++i) { const int ko = 256 * i + 4 * lane; f32x4 w;
                w = *(const LAS f32x4*)(w8s + 0 * 1024 + ko); d0 += (x[i][0] * w[0] + x[i][1] * w[1]) + (x[i][2] * w[2] + x[i][3] * w[3]);
                w = *(const LAS f32x4*)(w8s + 1 * 1024 + ko); d1 += (x[i][0] * w[0] + x[i][1] * w[1]) + (x[i][2] * w[2] + x[i][3] * w[3]);
                w = *(const LAS f32x4*)(w8s + 2 * 1024 + ko); d2 += (x[i][0] * w[0] + x[i][1] * w[1]) + (x[i][2] * w[2] + x[i][3] * w[3]);
                w = *(const LAS f32x4*)(w8s + 3 * 1024 + ko); d3 += (x[i][0] * w[0] + x[i][1] * w[1]) + (x[i][2] * w[2] + x[i][3] * w[3]);
                w = *(const LAS f32x4*)(w8s + 4 * 1024 + ko); d4 += (x[i][0] * w[0] + x[i][1] * w[1]) + (x[i][2] * w[2] + x[i][3] * w[3]);
                w = *(const LAS f32x4*)(w8s + 5 * 1024 + ko); d5 += (x[i][0] * w[0] + x[i][1] * w[1]) + (x[i][2] * w[2] + x[i][3] * w[3]);
                w = *(const LAS f32x4*)(w8s + 6 * 1024 + ko); d6 += (x[i][0] * w[0] + x[i][1] * w[1]) + (x[i][2] * w[2] + x[i][3] * w[3]);
                w = *(const LAS f32x4*)(w8s + 7 * 1024 + ko); d7 += (x[i][0] * w[0] + x[i][1] * w[1]) + (x[i][2] * w[2] + x[i][3] * w[3]); }
            d0 = wave_sum(d0); d1 = wave_sum(d1); d2 = wave_sum(d2); d3 = wave_sum(d3); d4 = wave_sum(d4); d5 = wave_sum(d5); d6 = wave_sum(d6); d7 = wave_sum(d7);
            if (lane < 4) { const float braw = lane == 0 ? d0 : (lane == 1 ? d1 : (lane == 2 ? d2 : d3)); const float araw = lane == 0 ? d4 : (lane == 1 ? d5 : (lane == 2 ? d6 : d7));
                const float xx = araw + dtb; const float sp = xx > 20.f ? xx : log1pf(expf(xx));
                ((float*)(a.ws + WS_BETA))[(size_t)row * 4 + lane] = 1.f / (1.f + expf(-braw));
                ((float*)(a.ws + WS_G))[(size_t)row * 4 + lane] = -expf(alog) * sp; }
        }
    }
}

struct SolveCtx { const LAS float* Mm; const LAS float* betas; const LAS float* egs; const LAS bf16_t* colp; float* UVs; bf16_t* WKs; bool isv; };
template <int I>
DI void solve_row(const SolveCtx& c, f32x2 (&xp)[32], f32x4 (&lc)[8], f32x4 (&ln)[8], float bcur, float ecur, bf16_t ccur) {
    float bnx = 0.f, enx = 0.f; bf16_t cnx = 0;
    if constexpr (I + 1 < 64) {
#pragma unroll
        for (int q = 0; q < 8; ++q) if (4 * q < I + 1) ln[q] = *(const LAS f32x4*)(c.Mm + (I + 1) * 64 + 4 * q);
        bnx = c.betas[I + 1]; enx = c.egs[I + 1]; cnx = c.colp[(I + 1) * 136]; }
    __builtin_amdgcn_sched_barrier(0);
    float sc = bcur; if (!c.isv) sc *= ecur;
    f32x2 a01 = {sc * bf2f(ccur), 0.f}, a23 = {0.f, 0.f};
#pragma unroll
    for (int q = 0; q < 16; ++q) if (4 * q < I) { f32x4 mv; if (q < 8) mv = lc[q < 8 ? q : 0]; else mv = *(const LAS f32x4*)(c.Mm + I * 64 + 4 * q);
        if (4 * q + 1 < I) a01 -= (f32x2){mv[0], mv[1]} * xp[2 * q]; else a01[0] -= mv[0] * xp[2 * q][0];
        if (4 * q + 3 < I) a23 -= (f32x2){mv[2], mv[3]} * xp[2 * q + 1]; else if (4 * q + 2 < I) a23[0] -= mv[2] * xp[2 * q + 1][0]; }
    const float xi = (a01[0] + a01[1]) + (a23[0] + a23[1]);
    xp[I >> 1][I & 1] = xi;
    if (c.isv) { if constexpr ((I & 3) == 3) *(f32x4*)(c.UVs + (size_t)((I >> 4) * 64 + ((I >> 2) & 3) * 16) * 4) = (f32x4){xp[(I >> 1) - 1][0], xp[(I >> 1) - 1][1], xp[I >> 1][0], xi}; }
    else c.WKs[I * 128] = f2bf(xi);
    __builtin_amdgcn_sched_barrier(0);
    if constexpr (I + 1 < 64) solve_row<I + 1>(c, xp, ln, lc, bnx, enx, cnx);
}

DI void dprep_item(LAS unsigned char* ldsh, const Args& a, int l, int item, int tl) {
    const int n = item & 31, h = (item >> 5) & 3, b = item >> 7;
    const int r0 = b * 2048 + n * 64;
    LAS bf16_t* qn = (LAS bf16_t*)ldsh; LAS bf16_t* kn = qn + 64 * 136; LAS bf16_t* vv = kn + 64 * 136;
    LAS float* Mm = (LAS float*)(ldsh + 3 * 17408);
    LAS float* gcs = (LAS float*)(ldsh + 3 * 17408 + 16384); LAS float* betas = gcs + 64; LAS float* egs = gcs + 128;
    const bf16_t* PROJ = (const bf16_t*)(a.ws + WS_HID);
    const float* BETA = (const float*)(a.ws + WS_BETA); const float* G = (const float*)(a.ws + WS_G);
    { const int cg4 = tl & 31, rg = tl >> 5, c0 = cg4 * 4;
      for (int sec = 0; sec < 3; ++sec) {
          const int col = sec * 512 + h * 128 + c0;
          f32x4 w[4];
#pragma unroll
          for (int i = 0; i < 4; ++i) w[i] = *(const f32x4*)(INP(a, 11) + (size_t)(l * 4 + i) * QKVD + col);
          f32x4 xin[11];
#pragma unroll
          for (int i = 0; i < 11; ++i) { const int tpos = n * 64 + rg * 8 - 3 + i;
              if (tpos >= 0) { const u32x2 raw = *(const u32x2*)(PROJ + (size_t)(r0 + rg * 8 - 3 + i) * NPROJ + col); xin[i] = (f32x4){bflo(raw.x), bfhi(raw.x), bflo(raw.y), bfhi(raw.y)}; }
              else xin[i] = (f32x4){0.f, 0.f, 0.f, 0.f}; }
          LAS bf16_t* dst = sec == 0 ? qn : (sec == 1 ? kn : vv);
#pragma unroll
          for (int j = 0; j < 8; ++j) { f32x4 o = w[0] * xin[j] + w[1] * xin[j + 1] + w[2] * xin[j + 2] + w[3] * xin[j + 3];
              o[0] = silu_f(o[0]); o[1] = silu_f(o[1]); o[2] = silu_f(o[2]); o[3] = silu_f(o[3]);
              if (sec < 2) { float ss = (o[0] * o[0] + o[1] * o[1]) + (o[2] * o[2] + o[3] * o[3]);
                  ss += __shfl_xor(ss, 16); ss += __shfl_xor(ss, 8); ss += __shfl_xor(ss, 4); ss += __shfl_xor(ss, 2); ss += __shfl_xor(ss, 1);
                  const float sc = rsqrtf(ss + 1e-6f) * (sec == 0 ? 0.08838834764831845f : 1.f); o = o * sc; }
              u32x2 pw; pw.x = pk2(o[0], o[1]); pw.y = pk2(o[2], o[3]); *(LAS u32x2*)(dst + (rg * 8 + j) * 136 + c0) = pw; }
      } }
    if (tl < 64) { float g = G[(size_t)(r0 + tl) * 4 + h];
#pragma unroll
        for (int o = 1; o < 64; o <<= 1) { const float t = __shfl_up(g, o); if (tl >= o) g += t; }
        gcs[tl] = g; betas[tl] = BETA[(size_t)(r0 + tl) * 4 + h]; const float eg = expf(g); egs[tl] = eg;
        egs[64 + tl] = __expf(__shfl(g, 63) - g);
        if (tl == 63) ((float*)(a.ws + WS_GE))[item] = eg; }
    __syncthreads();
    { const int wl = tl >> 6, lane = tl & 63, fr = lane & 15, fq = lane >> 4;
      bf16x8 ak[4], aq[4];
#pragma unroll
      for (int ks = 0; ks < 4; ++ks) { ak[ks] = *(const LAS bf16x8*)(kn + (16 * wl + fr) * 136 + 32 * ks + 8 * fq); aq[ks] = *(const LAS bf16x8*)(qn + (16 * wl + fr) * 136 + 32 * ks + 8 * fq); }
      bf16_t* QKs = (bf16_t*)(a.ws + WS_QK) + (size_t)item * 4096;
#pragma unroll
      for (int nt = 0; nt < 4; ++nt) { f32x4 ckk = {0.f, 0.f, 0.f, 0.f}, cqk = {0.f, 0.f, 0.f, 0.f};
#pragma unroll
          for (int ks = 0; ks < 4; ++ks) { const bf16x8 bb = *(const LAS bf16x8*)(kn + (16 * nt + fr) * 136 + 32 * ks + 8 * fq); ckk = MFMA16(ak[ks], bb, ckk); cqk = MFMA16(aq[ks], bb, cqk); }
          const int j = 16 * nt + fr; const float gj = gcs[j]; const int pj = perm6(j);
#pragma unroll
          for (int reg = 0; reg < 4; ++reg) { const int t = 16 * wl + 4 * fq + reg; const float dec = (j <= t) ? __expf(gcs[t] - gj) : 0.f;
              if (j < t) Mm[t * 64 + j] = betas[t] * ckk[reg] * dec;
              QKs[t * 64 + pj] = f2bf(cqk[reg] * dec); } }
      bf16_t* QDs = (bf16_t*)(a.ws + WS_QD) + (size_t)item * 8192;
      for (int e = tl; e < 1024; e += 256) { const int t = e >> 4, grp = e & 15, ks = grp >> 2, f2 = grp & 3; const float eg = egs[t];
          const u32x2 x0 = *(const LAS u32x2*)(qn + t * 136 + 32 * ks + 4 * f2), x1 = *(const LAS u32x2*)(qn + t * 136 + 32 * ks + 16 + 4 * f2);
          u32x4 w; w.x = pk2(bflo(x0.x) * eg, bfhi(x0.x) * eg); w.y = pk2(bflo(x0.y) * eg, bfhi(x0.y) * eg); w.z = pk2(bflo(x1.x) * eg, bfhi(x1.x) * eg); w.w = pk2(bflo(x1.y) * eg, bfhi(x1.y) * eg);
          *(u32x4*)(QDs + t * 128 + 32 * ks + 8 * f2) = w; }
      bf16_t* KETs = (bf16_t*)(a.ws + WS_KET) + (size_t)item * 8192; const float g63 = gcs[63];
      for (int e = tl; e < 1024; e += 256) { const int dk = e & 127, grp = e >> 7, ks = grp >> 2, f2 = grp & 3; float v[8];
#pragma unroll
          for (int i = 0; i < 8; ++i) { const int t = 32 * ks + 16 * (i >> 2) + 4 * f2 + (i & 3); v[i] = bf2f(kn[t * 136 + dk]) * egs[64 + t]; }
          u32x4 w; w.x = pk2(v[0], v[1]); w.y = pk2(v[2], v[3]); w.z = pk2(v[4], v[5]); w.w = pk2(v[6], v[7]);
          *(u32x4*)(KETs + dk * 64 + 32 * ks + 8 * f2) = w; }
    }
    __syncthreads();
    { const int c = tl; const bool isv = c < 128; const LAS bf16_t* colp = isv ? (vv + c) : (kn + (c - 128));
      float* UVs = (float*)(a.ws + WS_UV) + (size_t)item * 8192 + (size_t)(((c >> 4) & 7) * 4 * 64 + (c & 15)) * 4;
      bf16_t* WKs = (bf16_t*)(a.ws + WS_WK) + (size_t)item * 8192 + perm7(c & 127);
      f32x2 xp[32]; f32x4 mA[8], mB[8];
      SolveCtx sc_{Mm, betas, egs, colp, UVs, WKs, isv};
      mA[0] = *(const LAS f32x4*)(Mm + 64);
      { float sc = betas[0]; if (!isv) sc *= egs[0]; const float x0 = sc * bf2f(colp[0]); xp[0][0] = x0; if (!isv) WKs[0] = f2bf(x0); }
      solve_row<1>(sc_, xp, mA, mB, betas[1], egs[1], colp[136]);
    }
    __syncthreads();
}

DI void sample_item(LAS unsigned char* lds, const Args& a, int l, int item) {
    int tid_ = threadIdx.x; asm volatile("" : "+v"(tid_));
    const int tid = tid_, h = item & 3, b = item >> 2, row = NPROMPT + b;
    LAS float* vals = (LAS float*)lds;
    LAS float* red3 = vals + 384;
    LAS float* red = vals + 512;
    const bf16_t* PROJ = (const bf16_t*)(a.ws + WS_HID);
    float myv = 0.f;
    if (tid < 384) { const int sec = tid >> 7, c = tid & 127, col = sec * 512 + h * 128 + c;
        const float x0 = bf2f(PROJ[(size_t)row * NPROJ + col]);
        const float* sc = INP(a, 3) + (size_t)(l * 128 + b) * 3 * QKVD + col; const float* cw = INP(a, 11) + (size_t)l * 4 * QKVD + col;
        myv = silu_f(cw[0] * sc[0] + cw[QKVD] * sc[QKVD] + cw[2 * QKVD] * sc[2 * QKVD] + cw[3 * QKVD] * x0);
        vals[tid] = myv; }
    __syncthreads();
    if (tid < 192) { const int w = tid >> 6, lane = tid & 63; float s;
        if (w == 0) s = vals[lane] * vals[lane] + vals[lane + 64] * vals[lane + 64];
        else if (w == 1) s = vals[128 + lane] * vals[128 + lane] + vals[192 + lane] * vals[192 + lane];
        else s = vals[lane] * vals[128 + lane] + vals[lane + 64] * vals[192 + lane];
        s = wave_sum(s); if (lane == 0) red3[w] = s; }
    __syncthreads();
    const float qsc = rsqrtf(red3[0] + 1e-6f) * 0.08838834764831845f, ksc = rsqrtf(red3[1] + 1e-6f), qkdot = red3[2] * qsc * ksc;
    const float beta = ((const float*)(a.ws + WS_BETA))[(size_t)row * 4 + h], ga = expf(((const float*)(a.ws + WS_G))[(size_t)row * 4 + h]);
    const int dv4 = tid & 31, dkg = tid >> 5;
    const float* S0 = INP(a, 2) + (size_t)((l * 128 + b) * 4 + h) * 16384;
    f32x4 S[8]; f32x4 ks4 = {0.f, 0.f, 0.f, 0.f}, qs4 = {0.f, 0.f, 0.f, 0.f};
#pragma unroll
    for (int j = 0; j < 8; ++j) { const int dk = dkg * 8 + j; S[j] = __builtin_nontemporal_load((const f32x4*)(S0 + dk * 128 + dv4 * 4)); const float kk = vals[128 + dk] * ksc, qq = vals[dk] * qsc; ks4 += S[j] * kk; qs4 += S[j] * qq; }
    *(LAS f32x4*)(red + (dkg * 128 + dv4 * 4) * 2) = ks4; *(LAS f32x4*)(red + (dkg * 128 + dv4 * 4) * 2 + 4) = qs4;
    __syncthreads();
    f32x4 kS = {0.f, 0.f, 0.f, 0.f}, qS = {0.f, 0.f, 0.f, 0.f};
#pragma unroll
    for (int g = 0; g < 16; ++g) { kS += *(const LAS f32x4*)(red + (g * 128 + dv4 * 4) * 2); qS += *(const LAS f32x4*)(red + (g * 128 + dv4 * 4) * 2 + 4); }
    f32x4 v4 = *(const LAS f32x4*)(vals + 256 + dv4 * 4);
    const f32x4 u = v4 * beta - kS * (beta * ga);
    float* Sout = a.out + OUT_DS + (size_t)((l * 128 + b) * 4 + h) * 16384;
#pragma unroll
    for (int j = 0; j < 8; ++j) { const int dk = dkg * 8 + j; const float kk = vals[128 + dk] * ksc; __builtin_nontemporal_store(S[j] * ga + u * kk, (f32x4*)(Sout + dk * 128 + dv4 * 4)); }
    if (dkg == 0) { const f32x4 o = qS * ga + u * qkdot; *(f32x4*)((float*)(a.ws + WS_O) + (size_t)row * 512 + h * 128 + dv4 * 4) = o; }
    __syncthreads();
}

template <int W>
DI void pool_fill(LAS bf16_t* dA, const Args& a, int l, int g, int t0, int tid) {
    const bf16_t* PROJ = (const bf16_t*)(a.ws + WS_HID);
    const int c0 = (tid & 31) * 4, rg = tid >> 5, lr0 = rg * 8, row0 = t0 + lr0;
    if (t0 < NPROMPT) {
        const int tpos0 = row0 & 2047;
        const bf16_t* pp = PROJ + (size_t)row0 * NPROJ + 2048 + g * 128 + c0;
        f32x4 pv[W + 7];
#pragma unroll
        for (int i = 0; i < W + 7; ++i) { const int dr = i - (W - 1);
            if (tpos0 + dr >= 0) { const u32x2 rw = *(const u32x2*)(pp + (long)dr * NPROJ); pv[i] = (f32x4){bflo(rw.x), bfhi(rw.x), bflo(rw.y), bfhi(rw.y)}; }
            else pv[i] = (f32x4){0.f, 0.f, 0.f, 0.f}; }
#pragma unroll
        for (int j = 0; j < 8; ++j) { f32x4 sum = pv[j];
#pragma unroll
            for (int i = 1; i < W; ++i) sum += pv[j + i];
            const int tp = tpos0 + j; const float inv = 1.f / (float)((tp + 1 < W) ? tp + 1 : W);
            const f32x4 d = sum * inv - pv[j + W - 1]; u32x2 pw; pw.x = pk2(d[0], d[1]); pw.y = pk2(d[2], d[3]); *(LAS u32x2*)(dA + (lr0 + j) * 136 + c0) = pw; }
    } else {
#pragma unroll
        for (int j = 0; j < 8; ++j) { const int row = row0 + j; const bf16_t* pp = PROJ + (size_t)row * NPROJ + 2048 + g * 128 + c0;
            const u32x2 raw = *(const u32x2*)pp; const f32x4 p0 = {bflo(raw.x), bfhi(raw.x), bflo(raw.y), bfhi(raw.y)}; f32x4 sum = p0;
            const float* sp = INP(a, 4) + (size_t)(l * 128 + (row - NPROMPT)) * 15 * 512 + g * 128 + c0;
#pragma unroll
            for (int i = 1; i < W; ++i) sum += *(const f32x4*)(sp + (size_t)(15 - i) * 512);
            const f32x4 d = sum * (1.f / (float)W) - p0; u32x2 pw; pw.x = pk2(d[0], d[1]); pw.y = pk2(d[2], d[3]); *(LAS u32x2*)(dA + (lr0 + j) * 136 + c0) = pw; }
    }
}
DI void pool_item(LAS unsigned char* lds, const Args& a, int l, int item) {
    int tid_ = threadIdx.x; asm volatile("" : "+v"(tid_));
    const int tid = tid_, g = item & 3, rt = item >> 2, t0 = rt * 128;
    LAS bf16_t* dA = (LAS bf16_t*)lds; LAS bf16_t* wB = dA + 128 * 136;
    const bf16_t* PW = (const bf16_t*)(a.ws + WS_W + (size_t)l * W_LSTRIDE + WO_PW) + (size_t)g * 16384;
    for (int e = tid; e < 2048; e += 512) { const int r = e >> 4, c8 = (e & 15) * 8; *(LAS u32x4*)(wB + r * 136 + c8) = *(const u32x4*)(PW + r * 128 + c8); }
    if (g == 0) pool_fill<2>(dA, a, l, g, t0, tid); else if (g == 1) pool_fill<4>(dA, a, l, g, t0, tid); else if (g == 2) pool_fill<8>(dA, a, l, g, t0, tid); else pool_fill<16>(dA, a, l, g, t0, tid);
    __syncthreads();
    { const int w8 = tid >> 6, lane = tid & 63, fr = lane & 15, fq = lane >> 4;
      bf16x8 af[4];
#pragma unroll
      for (int ks = 0; ks < 4; ++ks) af[ks] = *(const LAS bf16x8*)(dA + (16 * w8 + fr) * 136 + 32 * ks + 8 * fq);
      bf16_t* MIX = (bf16_t*)(a.ws + WS_MIX); const float* psc = INP(a, 16) + l * 512 + g * 128;
#pragma unroll
      for (int nt = 0; nt < 8; ++nt) { f32x4 acc = {0.f, 0.f, 0.f, 0.f};
#pragma unroll
          for (int ks = 0; ks < 4; ++ks) { const bf16x8 bb = *(const LAS bf16x8*)(wB + (16 * nt + fr) * 136 + 32 * ks + 8 * fq); acc = MFMA16(af[ks], bb, acc); }
          const int col = 16 * nt + fr; const float sc = psc[col];
#pragma unroll
          for (int reg = 0; reg < 4; ++reg) MIX[(size_t)(t0 + 16 * w8 + 4 * fq + reg) * DM + 512 + g * 128 + col] = f2bf(acc[reg] * sc); } }
    __syncthreads();
}

DI void scan_phase(LAS unsigned char* lds, const Args& a, int l) {
    int tid_ = threadIdx.x; asm volatile("" : "+v"(tid_));
    const int tid = tid_, s = tid >> 6, lane = tid & 63, fr = lane & 15, fq = lane >> 4;
    constexpr int BUF = 62464, O_WK = 0, O_QD = 17408, O_KET = 34816, O_QK = 53248;
    const int lw0 = (tid >> 4) * 272 + (tid & 15) * 16, lw1 = ((tid + 512) >> 4) * 272 + (tid & 15) * 16;
    const int lk0 = (tid >> 3) * 144 + (tid & 7) * 16, lk1 = ((tid + 512) >> 3) * 144 + (tid & 7) * 16;
#define SC_LOADG(it_) do { const unsigned char* _w = a.ws + WS_WK + (size_t)(it_) * 16384 + tid * 16; const unsigned char* _q = a.ws + WS_QD + (size_t)(it_) * 16384 + tid * 16; \
        const unsigned char* _k = a.ws + WS_KET + (size_t)(it_) * 16384 + tid * 16; \
        pf[0] = *(const u32x4*)_w; pf[1] = *(const u32x4*)(_w + 8192); pf[2] = *(const u32x4*)_q; pf[3] = *(const u32x4*)(_q + 8192); \
        pf[4] = *(const u32x4*)_k; pf[5] = *(const u32x4*)(_k + 8192); pf[6] = *(const u32x4*)(a.ws + WS_QK + (size_t)(it_) * 8192 + tid * 16); \
        } while (0)
#define SC_LOADUV(it_) do { const float* _u = (const float*)(a.ws + WS_UV) + (size_t)(it_) * 8192 + s * 1024 + lane * 4; \
        uvn[0] = *(const f32x4*)_u; uvn[1] = *(const f32x4*)(_u + 256); uvn[2] = *(const f32x4*)(_u + 512); uvn[3] = *(const f32x4*)(_u + 768); \
        gen = ((const float*)(a.ws + WS_GE))[(it_)]; } while (0)
#define SC_STORE(bo_) do { LAS unsigned char* _b = lds + (bo_); \
        *(LAS u32x4*)(_b + O_WK + lw0) = pf[0]; *(LAS u32x4*)(_b + O_WK + lw1) = pf[1]; *(LAS u32x4*)(_b + O_QD + lw0) = pf[2]; *(LAS u32x4*)(_b + O_QD + lw1) = pf[3]; \
        *(LAS u32x4*)(_b + O_KET + lk0) = pf[4]; *(LAS u32x4*)(_b + O_KET + lk1) = pf[5]; *(LAS u32x4*)(_b + O_QK + lk0) = pf[6]; } while (0)
    for (int bh = blockIdx.x; bh < 32; bh += gridDim.x) {
        const int b = bh >> 2, h = bh & 3;
        const size_t item0 = (size_t)bh * 32;
        f32x4 S[8]; bf16x8 Sb[4];
#pragma unroll
        for (int i = 0; i < 8; ++i) S[i] = (f32x4){0.f, 0.f, 0.f, 0.f};
#pragma unroll
        for (int i = 0; i < 4; ++i) Sb[i] = (bf16x8){0, 0, 0, 0, 0, 0, 0, 0};
        u32x4 pf[7]; f32x4 uvn[4], uvc[4]; float gen, gec;
        SC_LOADG(item0); SC_LOADUV(item0);
        SC_STORE(0);
#pragma unroll
        for (int m = 0; m < 4; ++m) uvc[m] = uvn[m];
        gec = gen;
        SC_LOADG(item0 + 1);
        __syncthreads();
        float* O = (float*)(a.ws + WS_O);
        for (int n = 0; n < 32; ++n) {
            const int cur = (n & 1) * BUF;
            if (n + 1 < 32) { SC_STORE(BUF - cur); SC_LOADUV(item0 + n + 1); }
            if (n + 2 < 32) SC_LOADG(item0 + n + 2);
            const LAS unsigned char* B = lds + cur;
            f32x4 ws[4], o[4];
#pragma unroll
            for (int m = 0; m < 4; ++m) { ws[m] = (f32x4){0.f, 0.f, 0.f, 0.f}; o[m] = (f32x4){0.f, 0.f, 0.f, 0.f}; }
#pragma unroll
            for (int ks = 0; ks < 4; ++ks)
#pragma unroll
                for (int m = 0; m < 4; ++m) { const bf16x8 av = *(const LAS bf16x8*)(B + O_WK + (16 * m + fr) * 272 + (32 * ks + 8 * fq) * 2); ws[m] = MFMA16(av, Sb[ks], ws[m]); }
#pragma unroll
            for (int ks = 0; ks < 4; ++ks)
#pragma unroll
                for (int m = 0; m < 4; ++m) { const bf16x8 av = *(const LAS bf16x8*)(B + O_QD + (16 * m + fr) * 272 + (32 * ks + 8 * fq) * 2); o[m] = MFMA16(av, Sb[ks], o[m]); }
            f32x4 u[4];
#pragma unroll
            for (int m = 0; m < 4; ++m) u[m] = uvc[m] - ws[m];
            bf16x8 Ub[2]; Ub[0] = pack8(u[0], u[1]); Ub[1] = pack8(u[2], u[3]);
#pragma unroll
            for (int ks = 0; ks < 2; ++ks)
#pragma unroll
                for (int m = 0; m < 4; ++m) { const bf16x8 av = *(const LAS bf16x8*)(B + O_QK + (16 * m + fr) * 144 + (32 * ks + 8 * fq) * 2); o[m] = MFMA16(av, Ub[ks], o[m]); }
#pragma unroll
            for (int mt = 0; mt < 8; ++mt) S[mt] = S[mt] * gec;
#pragma unroll
            for (int ks = 0; ks < 2; ++ks)
#pragma unroll
                for (int mt = 0; mt < 8; ++mt) { const bf16x8 av = *(const LAS bf16x8*)(B + O_KET + (16 * mt + fr) * 144 + (32 * ks + 8 * fq) * 2); S[mt] = MFMA16(av, Ub[ks], S[mt]); }
#pragma unroll
            for (int ks = 0; ks < 4; ++ks) Sb[ks] = pack8(S[2 * ks], S[2 * ks + 1]);
            float* op = O + (size_t)(b * 2048 + n * 64 + 4 * fq) * 512 + h * 128 + 16 * s + fr;
#pragma unroll
            for (int m = 0; m < 4; ++m)
#pragma unroll
                for (int reg = 0; reg < 4; ++reg) op[(size_t)(16 * m + reg) * 512] = o[m][reg];
#pragma unroll
            for (int m = 0; m < 4; ++m) uvc[m] = uvn[m];
            gec = gen;
            __syncthreads();
        }
        float* dp = a.out + OUT_DP + (size_t)((l * 8 + b) * 4 + h) * 16384 + (size_t)(4 * fq) * 128 + 16 * s + fr;
#pragma unroll
        for (int mt = 0; mt < 8; ++mt)
#pragma unroll
            for (int reg = 0; reg < 4; ++reg) dp[(size_t)(16 * mt + reg) * 128] = S[mt][reg];
    }
#undef SC_LOADG
#undef SC_LOADUV
#undef SC_STORE
}

DI void gate_phase(const Args& a, int l) {
    int tid_ = threadIdx.x; asm volatile("" : "+v"(tid_));
    const int tid = tid_, wave = tid >> 6, lane = tid & 63;
    const float* O = (const float*)(a.ws + WS_O); const bf16_t* PROJ = (const bf16_t*)(a.ws + WS_HID); bf16_t* MIX = (bf16_t*)(a.ws + WS_MIX);
    const float* og = INP(a, 14) + l * 128 + (lane & 15) * 8;
    const f32x4 g0 = *(const f32x4*)og, g1 = *(const f32x4*)(og + 4);
    f32x4 n0 = {0.f, 0.f, 0.f, 0.f}, n1 = {0.f, 0.f, 0.f, 0.f}; u32x4 nz = {0u, 0u, 0u, 0u};
    { const int row = blockIdx.x * 8 + wave; if (row < NVALID) { n0 = *(const f32x4*)(O + (size_t)row * 512 + lane * 8); n1 = *(const f32x4*)(O + (size_t)row * 512 + lane * 8 + 4); nz = *(const u32x4*)(PROJ + (size_t)row * NPROJ + 1536 + lane * 8); } }
    for (int row = blockIdx.x * 8 + wave; row < NVALID; row += gridDim.x * 8) {
        const f32x4 o0 = n0, o1 = n1; const u32x4 zr = nz;
        { const int nrow = row + gridDim.x * 8; if (nrow < NVALID) { n0 = *(const f32x4*)(O + (size_t)nrow * 512 + lane * 8); n1 = *(const f32x4*)(O + (size_t)nrow * 512 + lane * 8 + 4); nz = *(const u32x4*)(PROJ + (size_t)nrow * NPROJ + 1536 + lane * 8); } }
        float ss = (o0[0] * o0[0] + o0[1] * o0[1]) + (o0[2] * o0[2] + o0[3] * o0[3]) + (o1[0] * o1[0] + o1[1] * o1[1]) + (o1[2] * o1[2] + o1[3] * o1[3]);
        ss += __shfl_xor(ss, 8); ss += __shfl_xor(ss, 4); ss += __shfl_xor(ss, 2); ss += __shfl_xor(ss, 1);
        const float rs = rsqrtf(ss * (1.f / 128.f) + 1e-6f);
        float r[8];
        r[0] = o0[0] * rs * g0[0] * silu_f(bflo(zr.x)); r[1] = o0[1] * rs * g0[1] * silu_f(bfhi(zr.x));
        r[2] = o0[2] * rs * g0[2] * silu_f(bflo(zr.y)); r[3] = o0[3] * rs * g0[3] * silu_f(bfhi(zr.y));
        r[4] = o1[0] * rs * g1[0] * silu_f(bflo(zr.z)); r[5] = o1[1] * rs * g1[1] * silu_f(bfhi(zr.z));
        r[6] = o1[2] * rs * g1[2] * silu_f(bflo(zr.w)); r[7] = o1[3] * rs * g1[3] * silu_f(bfhi(zr.w));
        u32x4 wv; wv.x = pk2(r[0], r[1]); wv.y = pk2(r[2], r[3]); wv.z = pk2(r[4], r[5]); wv.w = pk2(r[6], r[7]);
        *(u32x4*)(MIX + (size_t)row * DM + lane * 8) = wv;
    }
}

__global__ void __launch_bounds__(512) mk_fwd(Args a) {
    extern __shared__ __attribute__((aligned(16))) unsigned char lds_raw[];
    LAS unsigned char* lds = (LAS unsigned char*)lds_raw;
    cg::grid_group grid = cg::this_grid();
    const int G = gridDim.x;
    volatile LAS unsigned* xst = (volatile LAS unsigned*)(lds + LDS_MAIN);
    if (threadIdx.x < 4) xst[threadIdx.x] = 0u;
    __syncthreads();
    (void)xcd_barrier_post((unsigned*)(a.ws + WS_BAR), xst);
    for (int ph = a.ph_lo; ph < a.ph_hi; ++ph) {
        if (ph > a.ph_lo) { if (a.ph_lo < 0) grid.sync();   { XcdBarrier xbar; xbar.bar = (unsigned*)(a.ws + WS_BAR); xbar.x = xb_xcc_id(); xbar.st = (volatile LAS unsigned*)(lds + LDS_MAIN); xcd_barrier(xbar); } }
        if (ph == 0) { if (PHON(0)) prep_phase(lds, a); continue; }
        const int l = (ph - 1) / 12, k = (ph - 1) % 12;
        const unsigned char* Wl = a.ws + WS_W + (size_t)l * W_LSTRIDE;
        if (PHON(1) && (k == 0 || k == 9)) {
            pg8::Gemm g{(const bf16_t*)(a.ws + WS_XB), (const bf16_t*)(Wl + (k == 0 ? WO_GU1 : WO_GU2)), ROWS, 5632, DM};
            pg8::StaticOrder S; S.init(ROWS, 5632, DM, G, (int)blockIdx.x, 0);
            EpiSwiglu E{(bf16_t*)(a.ws + WS_HID)};
            pg8::gemm_phase<EpiSwiglu, pg8::StaticOrder>(lds, g, S, E);
        } else if (PHON(2) && (k == 1 || k == 10 || k == 7)) {
            pg8::Gemm g{(const bf16_t*)(a.ws + (k == 7 ? WS_MIX : WS_HID)), (const bf16_t*)(Wl + (k == 1 ? WO_D1 : (k == 10 ? WO_D2 : WO_WOUT))), ROWS, DM, k == 7 ? DM : FF};
            pg8::StaticOrder S; S.init(NPROMPT, DM, k == 7 ? DM : FF, G, (int)blockIdx.x, k == 7 ? 4 : 11);
            EpiResid E{(float*)(a.ws + WS_R), (float*)(a.ws + WS_PART), k == 7 ? 1.0f : 0.5f};
            pg8::gemm_phase<EpiResid, pg8::StaticOrder>(lds, g, S, E);
        } else if (PHON(3) && (k == 2 || k == 8 || k == 11)) {
            ln_phase(lds, a, l, k == 2 ? 1 : (k == 8 ? 2 : 3));
        } else if (PHON(4) && k == 3) {
            pg8::Gemm g{(const bf16_t*)(a.ws + WS_XB), (const bf16_t*)(Wl + WO_WIN), ROWS, NPROJ, DM};
            pg8::StaticOrder S; S.init(ROWS, NPROJ, DM, G, (int)blockIdx.x, 0);
            EpiProj E{(bf16_t*)(a.ws + WS_HID), a.out, l};
            pg8::gemm_phase<EpiProj, pg8::StaticOrder>(lds, g, S, E);
        } else if (k == 4) {
            for (int it = blockIdx.x; it < 512; it += G) {
                if (PHON(5)) { int tq = threadIdx.x; asm volatile("" : "+v"(tq)); const int hb = tq >> 8; dprep_item(lds + hb * 69632, a, l, it * 2 + hb, tq & 255); }
            }
        } else if (PHON(8) && k == 5) {
            if ((int)blockIdx.x < 32 || G <= 32) scan_phase(lds, a, l);
            if (G <= 32) __syncthreads();
            if ((int)blockIdx.x >= 32 || G <= 32) {
                const int nb = (G > 32) ? G - 32 : G, b0 = (G > 32) ? (int)blockIdx.x - 32 : (int)blockIdx.x;
                for (int it = b0; it < 512 + 516; it += nb) {
                    if (PHON(6) && it < 512) sample_item(lds, a, l, it);
                    else if (PHON(7) && it >= 512) pool_item(lds, a, l, it - 512);
                }
            }
        } else if (PHON(9) && k == 6) {
            gate_phase(a, l);
        }
    }
}

extern "C" void kernel_launch(void* const* d_in, const int* in_sizes, int n_in, void* d_out, int out_size, void* d_ws, size_t ws_size, hipStream_t stream) {
    static int grid = 0;
    if (grid == 0) {
        if (n_in != 25 || ws_size < WS_END) { fprintf(stderr, "kernel_launch: need 25 inputs and >= %zu bytes of workspace; got %d, %zu\n", (size_t)WS_END, n_in, ws_size); grid = -1; return; }
        int dev = 0, cus = 0, per_cu = 0;
        hipGetDevice(&dev); hipDeviceGetAttribute(&cus, hipDeviceAttributeMultiprocessorCount, dev);
        if (hipFuncSetAttribute((const void*)mk_fwd, hipFuncAttributeMaxDynamicSharedMemorySize, LDS_BYTES) != hipSuccess) { fprintf(stderr, "kernel_launch: hipFuncSetAttribute failed\n"); grid = -1; return; }
        if (hipOccupancyMaxActiveBlocksPerMultiprocessor(&per_cu, (const void*)mk_fwd, 512, LDS_BYTES) != hipSuccess || per_cu < 1) { fprintf(stderr, "kernel_launch: occupancy query gave %d\n", per_cu); per_cu = 1; }
        (void)hipGetLastError();
        grid = cus * 1;
        if (grid <= 0) grid = 256;
    }
    if (grid < 0) return;
    Args a{};
    for (int i = 0; i < 25; ++i) a.in[i] = (const float*)d_in[i];
    a.out = (float*)d_out; a.ws = (unsigned char*)d_ws;
#if MK_MULTI
    for (int ph = 0; ph < NPH; ++ph) { a.ph_lo = ph; a.ph_hi = ph + 1; hipLaunchKernelGGL(mk_fwd, dim3(grid), dim3(512), LDS_BYTES, stream, a); }
#else
    a.ph_lo = 0; a.ph_hi = NPH;
    if (hipMemsetAsync((char*)d_ws + WS_BAR, 0, 16384, stream) != hipSuccess) { fprintf(stderr, "kernel_launch: memset of barrier words failed\n"); return; }
    void* args[] = {&a};
    hipError_t e = hipLaunchCooperativeKernel((const void*)mk_fwd, dim3(grid), dim3(512), args, LDS_BYTES, stream);
    if (e != hipSuccess) fprintf(stderr, "cooperative launch failed: %s (grid %d)\n", hipGetErrorString(e), grid);
#endif
}
```

```cpp
#include <hip/hip_runtime.h>
#include <hip/hip_cooperative_groups.h>
#include <cstdio>
namespace cg = cooperative_groups;

#ifndef MK_MULTI
#define MK_MULTI 0
#endif

#ifndef PHMASK
#define PHMASK 0xFFFF
#endif
#define PHON(i) ((PHMASK >> (i)) & 1)
#define LAS __attribute__((address_space(3)))
typedef unsigned short bf16_t;
typedef short bf16x8 __attribute__((ext_vector_type(8)));
typedef float f32x4 __attribute__((ext_vector_type(4)));
typedef float f32x2 __attribute__((ext_vector_type(2)));
typedef unsigned u32x4 __attribute__((ext_vector_type(4)));
typedef unsigned u32x2 __attribute__((ext_vector_type(2)));
typedef __bf16 nbf2 __attribute__((ext_vector_type(2)));
#define DI __device__ __forceinline__

constexpr int DM = 1024, FF = 2816, NPROMPT = 16384, NSAMP = 128, NVALID = 16512, ROWS = 16640, DEPTH = 4;
constexpr int NPROJ = 2560, INDIM = 2568, QKVD = 1536;
constexpr float ALPHA = 1.681792830507429f;
constexpr int LDS_MAIN = 139264, LDS_BYTES = LDS_MAIN + 16;
constexpr int NPH = 1 + 12 * DEPTH;

constexpr size_t SZ_GU = (size_t)5632 * 1024 * 2, SZ_D = (size_t)1024 * 2816 * 2, SZ_WIN = (size_t)2560 * 1024 * 2, SZ_WOUT = (size_t)1024 * 1024 * 2, SZ_PW = (size_t)4 * 128 * 128 * 2;
constexpr size_t WO_GU1 = 0, WO_D1 = WO_GU1 + SZ_GU, WO_WIN = WO_D1 + SZ_D, WO_WOUT = WO_WIN + SZ_WIN, WO_GU2 = WO_WOUT + SZ_WOUT, WO_D2 = WO_GU2 + SZ_GU, WO_PW = WO_D2 + SZ_D, W_LSTRIDE = WO_PW + SZ_PW;
constexpr size_t WS_W = 0;
constexpr size_t WS_R = WS_W + DEPTH * W_LSTRIDE;
constexpr size_t WS_XB = WS_R + (size_t)ROWS * DM * 4;
constexpr size_t WS_HID = WS_XB + (size_t)ROWS * DM * 2;
constexpr size_t WS_MIX = WS_HID + (size_t)ROWS * FF * 2;
constexpr size_t WS_O = WS_MIX + (size_t)ROWS * DM * 2;
constexpr size_t WS_BETA = WS_O + (size_t)ROWS * 512 * 4;
constexpr size_t WS_G = WS_BETA + (size_t)ROWS * 16;
constexpr size_t WS_UV = WS_G + (size_t)ROWS * 16;
constexpr size_t WS_WK = WS_UV + (size_t)1024 * 8192 * 4;
constexpr size_t WS_QD = WS_WK + (size_t)1024 * 8192 * 2;
constexpr size_t WS_KET = WS_QD + (size_t)1024 * 8192 * 2;
constexpr size_t WS_QK = WS_KET + (size_t)1024 * 8192 * 2;
constexpr size_t WS_GE = WS_QK + (size_t)1024 * 4096 * 2;
constexpr size_t WS_BAR = WS_GE + 4096;
constexpr size_t WS_PART = WS_BAR + 16384;
constexpr size_t WS_END = WS_PART + (size_t)11 * 256 * 1024 * 4;

constexpr size_t OUT_YP = 0, OUT_YS = 16777216, OUT_DP = 16908288, OUT_CP = 19005440, OUT_PP = 19152896, OUT_DS = 19398656, OUT_CS = 52953088, OUT_PS = 55312384;

struct Args { const float* in[25]; float* out; unsigned char* ws; int ph_lo, ph_hi; };

DI const float* INP(const Args& a, int i) { asm volatile("" : "+s"(i)); return a.in[i]; }
DI unsigned pk2(float a, float b) { f32x2 v = {a, b}; nbf2 r = __builtin_convertvector(v, nbf2); return __builtin_bit_cast(unsigned, r); }
DI bf16_t f2bf(float a) { return (bf16_t)(pk2(a, 0.f) & 0xffffu); }
DI float bflo(unsigned w) { return __uint_as_float(w << 16); }
DI float bfhi(unsigned w) { return __uint_as_float(w & 0xffff0000u); }
DI float bf2f(bf16_t b) { return __uint_as_float(((unsigned)b) << 16); }
DI float silu_f(float x) { return x * __builtin_amdgcn_rcpf(1.f + __expf(-x)); }
DI float wave_sum(float v) {
#pragma unroll
    for (int o = 32; o > 0; o >>= 1) v += __shfl_xor(v, o);
    return v;
}
DI bf16x8 pack8(const f32x4& a, const f32x4& b) { u32x4 p; p.x = pk2(a[0], a[1]); p.y = pk2(a[2], a[3]); p.z = pk2(b[0], b[1]); p.w = pk2(b[2], b[3]); return __builtin_bit_cast(bf16x8, p); }
DI int perm6(int j) { return (j & 32) | (((j >> 2) & 3) << 3) | (((j >> 4) & 1) << 2) | (j & 3); }
DI int perm7(int j) { return (j & 96) | (((j >> 2) & 3) << 3) | (((j >> 4) & 1) << 2) | (j & 3); }
#define MFMA16(a, b, c) __builtin_amdgcn_mfma_f32_16x16x32_bf16((a), (b), (c), 0, 0, 0)


#define XB_TMO      128
#define XB_XCNT(j)  (256  + 64 * (j))
#define XB_XSUB(j)  (1280 + 64 * (j))
#define XB_XGEN(j)  (2304 + 64 * (j))
#define XB_TOP      3328
#define XB_TOPGEN   3392
#define XCD_BAR_WORDS 3456
#define XB_SPIN_CAP (1u << 22)
DI unsigned xb_ld(unsigned* p)              { return __hip_atomic_load(p, __ATOMIC_RELAXED, __HIP_MEMORY_SCOPE_AGENT); }
DI unsigned xb_add(unsigned* p, unsigned v) { return __hip_atomic_fetch_add(p, v, __ATOMIC_RELAXED, __HIP_MEMORY_SCOPE_AGENT); }
DI unsigned xb_xcc_id() { return (unsigned)__builtin_amdgcn_s_getreg((3 << 11) | 20) & 0xFu; }
#define XB_SPIN(cond, bar) do { unsigned _sp = 0; while (cond) { __builtin_amdgcn_s_sleep(1); \
    if ((++_sp & 255u) == 0u) { if (xb_ld(&(bar)[XB_TMO])) break; if (_sp > XB_SPIN_CAP) { atomicAdd(&(bar)[XB_TMO], 1u); break; } } } } while (0)
struct XcdBarrier { unsigned* bar; unsigned x; volatile LAS unsigned* st; };
DI XcdBarrier xcd_barrier_post(unsigned* bar, volatile LAS unsigned* st) {
    XcdBarrier b; b.bar = bar; b.x = xb_xcc_id(); b.st = st;
    if (threadIdx.x == 0) (void)xb_add(&bar[XB_XCNT(b.x)], 1u);
    return b;
}
DI void xcd_barrier_complete(unsigned* bar, unsigned x, unsigned& nloc, unsigned& nx) {
    const unsigned G = gridDim.x * gridDim.y * gridDim.z;
    unsigned sum, cnt, mine, sp = 0u;
    for (;;) {
        sum = 0u; cnt = 0u; mine = 0u;
#pragma unroll
        for (unsigned j = 0; j < 16; ++j) { const unsigned c = xb_ld(&bar[XB_XCNT(j)]); sum += c; cnt += (c > 0u) ? 1u : 0u; mine = (j == x) ? c : mine; }
        if (sum == G) break;
        __builtin_amdgcn_s_sleep(1);
        if ((++sp & 255u) == 0u) { if (xb_ld(&bar[XB_TMO])) break; if (sp > XB_SPIN_CAP) { atomicAdd(&bar[XB_TMO], 1u); break; } }
    }
    nloc = mine > 0u ? mine : 1u; nx = cnt > 0u ? cnt : 1u;
}
DI void xcd_barrier(const XcdBarrier& b) {
    asm volatile("s_waitcnt vmcnt(0)" ::: "memory");
    __syncthreads();
    if (threadIdx.x == 0) {
        unsigned* bar = b.bar;
        __builtin_amdgcn_s_waitcnt(0);
        unsigned nloc = b.st[0], nx = b.st[1];
        if (nloc == 0u) { xcd_barrier_complete(bar, b.x, nloc, nx); b.st[0] = nloc; b.st[1] = nx; }
        const unsigned old = xb_add(&bar[XB_XSUB(b.x)], 1u);
        const unsigned gen = old / nloc;
        if (old + 1u == (gen + 1u) * nloc) {
            __builtin_amdgcn_fence(__ATOMIC_RELEASE, "agent");
            asm volatile("s_waitcnt vmcnt(0)" ::: "memory");
            const unsigned og = xb_add(&bar[XB_TOP], 1u);
            const unsigned tg = og / nx;
            if (og + 1u == (tg + 1u) * nx) xb_add(&bar[XB_TOPGEN], 1u);
            else XB_SPIN(xb_ld(&bar[XB_TOPGEN]) == tg, bar);
            __builtin_amdgcn_fence(__ATOMIC_ACQUIRE, "agent");
            xb_add(&bar[XB_XGEN(b.x)], 1u);
            asm volatile("s_waitcnt vmcnt(0)" ::: "memory");
        } else {
            XB_SPIN(xb_ld(&bar[XB_XGEN(b.x)]) == gen, bar);
            __builtin_amdgcn_fence(__ATOMIC_ACQUIRE, "agent");
            asm volatile("s_waitcnt vmcnt(0)" ::: "memory");
        }
    }
    __syncthreads();
}

namespace pg8 {
constexpr int BM = 256, BK = 64, HALF = 128, HTB = HALF * BK * 2, STAGE_BYTES = 8 * HTB, NXCD = 8, WGM = 8;
DI int lds_byte(int r, int c) { const int st = (r >> 4) * 2 + (c >> 5), rr = r & 15, cc = c & 31, ob = rr * 64 + cc * 2; return st * 1024 + (ob ^ (((ob >> 9) & 1) << 5)); }
DI void stage_rc(int b, int& R, int& C) { const int st = b / 1024, sb = b % 1024, swz = sb ^ (((sb >> 9) & 1) << 5); R = (st >> 1) * 16 + swz / 64; C = (st & 1) * 32 + (swz % 64) / 2; }
struct Unit { int pm, pn, kt0, nt, split; };
struct Gemm { const bf16_t* A; const bf16_t* Bt; int M, N, K; };
struct StaticOrder {
    int nM, nN, nwg, G, c, ntFull, ntSplit, ntot;
    DI void init(int M, int N, int K, int G_, int c_, int parts) { nM = M / BM; nN = N / BM; nwg = nM * nN; G = G_; c = c_; ntFull = K / BK; ntSplit = parts > 0 ? ntFull / parts : ntFull; ntot = nwg + 4 * parts; }
    DI bool next(int i, Unit& u) const {
        const int L = i * G + c;
        if (L >= ntot) return false;
        const bool sp = L >= nwg;
        int wgid = sp ? 0 : L; { const int q = nwg / NXCD, r = nwg % NXCD, xcd = wgid % NXCD, off = wgid / NXCD; wgid = (xcd < r ? xcd * (q + 1) : r * (q + 1) + (xcd - r) * q) + off; }
        const int nig = WGM * nN, gid = wgid / nig, fm = gid * WGM, gsz = (nM - fm) < WGM ? (nM - fm) : WGM;
        const int pm_s = fm + ((wgid % nig) % gsz), pn_s = (wgid % nig) / gsz;
        const int j = sp ? L - nwg : 0;
        u.pm = sp ? nM : pm_s; u.pn = sp ? (j & 3) : pn_s; u.kt0 = sp ? (j >> 2) * ntSplit : 0; u.nt = sp ? ntSplit : ntFull; u.split = sp ? 1 : 0;
        return true;
    }
};

template <class Epi, class Sched>
DI void gemm_phase(LAS unsigned char* lds, const Gemm g, const Sched& S, const Epi& E) {
    int tid_ = threadIdx.x; asm volatile("" : "+v"(tid_));
    const int tid = tid_, wid = __builtin_amdgcn_readfirstlane(tid >> 6), lane = tid & 63, wr = wid >> 2, wc = wid & 3, fr = lane & 15, fq = lane >> 4;
    const int K = g.K;
    unsigned voffA[2], voffB[2];
#pragma unroll
    for (int i = 0; i < 2; ++i) { int R, C; stage_rc(tid * 16 + i * 8192, R, C); voffA[i] = (unsigned)(R * K + C) * 2u; voffB[i] = voffA[i]; }
    const size_t kstep = (size_t)(BK * 2);
    const size_t hstep = (size_t)HALF * K * 2;
    const size_t tstep = 2 * hstep;
    const unsigned ldsw = (unsigned)wid * 1024u;
    const int aoff = lds_byte(wr * 64 + fr, fq * 8), boff = lds_byte(wc * 32 + fr, fq * 8);
#define PG8_SA(b, h) (((b) * 2 + (h)) * HTB)
#define PG8_SB(b, h) ((4 + (b) * 2 + (h)) * HTB)
#define PG8_STAGE(bufoff, gbase, voff) do { _Pragma("unroll") for (int _i = 0; _i < 2; ++_i) \
        __builtin_amdgcn_global_load_lds((const unsigned*)((const char*)(gbase) + (voff)[_i]), (LAS unsigned*)(lds + (bufoff) + ldsw + _i * 8192), 16, 0, 0); } while (0)
#define PG8_LDA(dst, b, h) do { _Pragma("unroll") for (int m = 0; m < 4; ++m) _Pragma("unroll") for (int k = 0; k < 2; ++k) dst[m][k] = *(const LAS bf16x8*)(lds + PG8_SA(b, h) + aoff + m * 2048 + k * 1024); } while (0)
#define PG8_LDB(dst, b, h) do { _Pragma("unroll") for (int n = 0; n < 2; ++n) _Pragma("unroll") for (int k = 0; k < 2; ++k) dst[n][k] = *(const LAS bf16x8*)(lds + PG8_SB(b, h) + boff + n * 2048 + k * 1024); } while (0)
#define PG8_MMA(ai, bj, At, Bt) do { __builtin_amdgcn_s_setprio(1); _Pragma("unroll") for (int m = 0; m < 4; ++m) _Pragma("unroll") for (int n = 0; n < 2; ++n) _Pragma("unroll") for (int k = 0; k < 2; ++k) \
        acc[ai][bj][m][n] = __builtin_amdgcn_mfma_f32_16x16x32_bf16(Bt[n][k], At[m][k], acc[ai][bj][m][n], 0, 0, 0); __builtin_amdgcn_s_setprio(0); } while (0)
#define PG8_WAIT_V(n) asm volatile("s_waitcnt vmcnt(" #n ")" ::: "memory")
#define PG8_WAIT_L(n) asm volatile("s_waitcnt lgkmcnt(" #n ")" ::: "memory")
#define PG8_BAR __builtin_amdgcn_s_barrier()
#define PG8_SCHED __builtin_amdgcn_sched_barrier(0)
    Unit cur, nxt; int ui = 0;
    if (!S.next(0, cur)) return;
    f32x4 acc[2][2][4][2];
#pragma unroll
    for (int a = 0; a < 2; ++a)
#pragma unroll
        for (int b = 0; b < 2; ++b)
#pragma unroll
            for (int m = 0; m < 4; ++m)
#pragma unroll
                for (int n = 0; n < 2; ++n) acc[a][b][m][n] = (f32x4){0.f, 0.f, 0.f, 0.f};
    bf16x8 At[4][2], B0[2][2], B1[2][2];
    const char* cA = (const char*)g.A + (size_t)cur.pm * tstep + (size_t)cur.kt0 * kstep; const char* cB = (const char*)g.Bt + (size_t)cur.pn * tstep + (size_t)cur.kt0 * kstep;
    PG8_STAGE(PG8_SB(0, 0), cB, voffB); PG8_STAGE(PG8_SA(0, 0), cA, voffA); PG8_STAGE(PG8_SB(0, 1), cB + hstep, voffB); PG8_STAGE(PG8_SA(0, 1), cA + hstep, voffA);
    if (wr == 1) PG8_BAR;
    PG8_WAIT_V(4); PG8_BAR;
    PG8_STAGE(PG8_SB(1, 0), cB + kstep, voffB); PG8_STAGE(PG8_SA(1, 0), cA + kstep, voffA); PG8_STAGE(PG8_SB(1, 1), cB + hstep + kstep, voffB);
    PG8_WAIT_V(6); PG8_BAR;
    for (;;) {
        const bool has_next = S.next(ui + 1, nxt);
        const char* nA = has_next ? (const char*)g.A + (size_t)nxt.pm * tstep + (size_t)nxt.kt0 * kstep : cA; const char* nB = has_next ? (const char*)g.Bt + (size_t)nxt.pn * tstep + (size_t)nxt.kt0 * kstep : cB;
        const int nt = cur.nt;
        for (int t = 0; t < nt; t += 2) {
            const bool last = (t == nt - 2);
            const char* a1 = cA + (size_t)(t + 1) * kstep;
            const char* a2 = last ? nA : cA + (size_t)(t + 2) * kstep; const char* b2 = last ? nB : cB + (size_t)(t + 2) * kstep;
            const char* a3 = a2 + kstep; const char* b3 = b2 + kstep;
            PG8_LDB(B0, 0, 0); PG8_SCHED; PG8_LDA(At, 0, 0); PG8_STAGE(PG8_SA(1, 1), a1 + hstep, voffA);
            PG8_WAIT_L(8); PG8_BAR; PG8_WAIT_L(0); PG8_MMA(0, 0, At, B0); PG8_BAR; PG8_SCHED;
            PG8_LDB(B1, 0, 1); PG8_STAGE(PG8_SB(0, 0), b2, voffB);
            PG8_BAR; PG8_WAIT_L(0); PG8_MMA(0, 1, At, B1); PG8_BAR;
            PG8_LDA(At, 0, 1); PG8_STAGE(PG8_SA(0, 0), a2, voffA);
            PG8_BAR; PG8_WAIT_L(0); PG8_MMA(1, 0, At, B0); PG8_BAR; PG8_SCHED;
            PG8_STAGE(PG8_SB(0, 1), b2 + hstep, voffB);
            PG8_WAIT_V(6); PG8_BAR; PG8_MMA(1, 1, At, B1); PG8_BAR;
            PG8_LDB(B0, 1, 0); PG8_SCHED; PG8_LDA(At, 1, 0); PG8_STAGE(PG8_SA(0, 1), a2 + hstep, voffA);
            PG8_WAIT_L(8); PG8_BAR; PG8_WAIT_L(0); PG8_MMA(0, 0, At, B0); PG8_BAR; PG8_SCHED;
            PG8_LDB(B1, 1, 1); PG8_STAGE(PG8_SB(1, 0), b3, voffB);
            PG8_BAR; PG8_WAIT_L(0); PG8_MMA(0, 1, At, B1); PG8_BAR;
            PG8_LDA(At, 1, 1); PG8_STAGE(PG8_SA(1, 0), a3, voffA);
            PG8_BAR; PG8_WAIT_L(0); PG8_MMA(1, 0, At, B0); PG8_BAR; PG8_SCHED;
            PG8_STAGE(PG8_SB(1, 1), b3 + hstep, voffB);
            PG8_WAIT_V(6); PG8_BAR; PG8_MMA(1, 1, At, B1); PG8_BAR;
        }
        E(acc, cur, wr, wc, fr, fq);
        if (!has_next) break;
#pragma unroll
        for (int a = 0; a < 2; ++a)
#pragma unroll
            for (int b = 0; b < 2; ++b)
#pragma unroll
                for (int m = 0; m < 4; ++m)
#pragma unroll
                    for (int n = 0; n < 2; ++n) acc[a][b][m][n] = (f32x4){0.f, 0.f, 0.f, 0.f};
        cur = nxt; cA = nA; cB = nB; ++ui;
    }
    PG8_WAIT_V(0);
    if (wr == 0) PG8_BAR;
    PG8_BAR;
#undef PG8_SA
#undef PG8_SB
#undef PG8_STAGE
#undef PG8_LDA
#undef PG8_LDB
#undef PG8_MMA
#undef PG8_WAIT_V
#undef PG8_WAIT_L
#undef PG8_BAR
#undef PG8_SCHED
}
}

struct EpiResid {
    float* R; float* PART; float scale;
    DI void operator()(const f32x4 (&acc)[2][2][4][2], const pg8::Unit& u, int wr, int wc, int fr, int fq) const {
        const int row0 = u.pm * 256 + wr * 64 + fr, col0 = u.pn * 256 + wc * 32 + 4 * fq;
        const bf16_t* XBr = (const bf16_t*)((const unsigned char*)R + (WS_XB - WS_R));
        if (u.split) {
            float* P0 = PART + ((size_t)(u.kt0 / u.nt) * 256 + (wr * 64 + fr)) * DM + col0;
#pragma unroll
            for (int ai = 0; ai < 2; ++ai)
#pragma unroll
                for (int m = 0; m < 4; ++m) { float* rowp = P0 + (size_t)(ai * 128 + m * 16) * DM;
#pragma unroll
                    for (int bj = 0; bj < 2; ++bj)
#pragma unroll
                        for (int n = 0; n < 2; ++n) *(f32x4*)(rowp + bj * 128 + n * 16) = acc[ai][bj][m][n] * scale; }
            return; }
#pragma unroll
        for (int ai = 0; ai < 2; ++ai)
#pragma unroll
            for (int m = 0; m < 4; ++m) { float* rowp = R + (size_t)(row0 + ai * 128 + m * 16) * DM + col0;
#pragma unroll
                for (int bj = 0; bj < 2; ++bj)
#pragma unroll
                    for (int n = 0; n < 2; ++n) { const u32x2 hb = *(const u32x2*)(XBr + (size_t)(row0 + ai * 128 + m * 16) * DM + col0 + bj * 128 + n * 16);
                        const f32x4 r = (f32x4){bflo(hb.x), bfhi(hb.x), bflo(hb.y), bfhi(hb.y)} * ALPHA; *(f32x4*)(rowp + bj * 128 + n * 16) = r + acc[ai][bj][m][n] * scale; }
                if (m & 1) asm volatile("" ::: "memory"); }
    }
};
struct EpiSwiglu {
    bf16_t* H;
    DI void operator()(const f32x4 (&acc)[2][2][4][2], const pg8::Unit& u, int wr, int wc, int fr, int fq) const {
        const int row0 = u.pm * 256 + wr * 64 + fr, col0 = u.pn * 128 + wc * 32 + 8 * fq;
#pragma unroll
        for (int ai = 0; ai < 2; ++ai)
#pragma unroll
            for (int m = 0; m < 4; ++m) { bf16_t* rowp = H + (size_t)(row0 + ai * 128 + m * 16) * FF + col0;
                float h[8];
#pragma unroll
                for (int bj = 0; bj < 2; ++bj)
#pragma unroll
                    for (int j = 0; j < 4; j += 2) { const f32x2 g2 = {acc[ai][bj][m][0][j], acc[ai][bj][m][0][j + 1]}, u2 = {acc[ai][bj][m][1][j], acc[ai][bj][m][1][j + 1]};
                        const f32x2 t2 = g2 * (-1.4426950408889634f); f32x2 e2; e2[0] = __builtin_amdgcn_exp2f(t2[0]); e2[1] = __builtin_amdgcn_exp2f(t2[1]);
                        const f32x2 d2 = e2 + 1.0f; f32x2 r2; r2[0] = __builtin_amdgcn_rcpf(d2[0]); r2[1] = __builtin_amdgcn_rcpf(d2[1]);
                        const f32x2 h2 = (g2 * u2) * r2; h[bj * 4 + j] = h2[0]; h[bj * 4 + j + 1] = h2[1]; }
                u32x4 w; w.x = pk2(h[0], h[1]); w.y = pk2(h[2], h[3]); w.z = pk2(h[4], h[5]); w.w = pk2(h[6], h[7]);
                *(u32x4*)rowp = w; asm volatile("" ::: "memory"); }
    }
};
struct EpiProj {
    bf16_t* P; float* out; int layer;
    DI void operator()(const f32x4 (&acc)[2][2][4][2], const pg8::Unit& u, int wr, int wc, int fr, int fq) const {
        const int row0 = u.pm * 256 + wr * 64 + fr, colL = wc * 32 + 8 * fq;
        const bool special = ((u.pm & 7) == 7 || u.pm == 64) && (u.pn < 6 || u.pn >= 8);
#pragma unroll
        for (int ai = 0; ai < 2; ++ai)
#pragma unroll
            for (int m = 0; m < 4; ++m) { const int r = row0 + ai * 128 + m * 16;
#pragma unroll
                for (int bj = 0; bj < 2; ++bj) { const int pc = u.pn * 256 + bj * 128 + colL; const f32x4 v0 = acc[ai][bj][m][0], v1 = acc[ai][bj][m][1];
                    u32x4 w; w.x = pk2(v0[0], v0[1]); w.y = pk2(v0[2], v0[3]); w.z = pk2(v1[0], v1[1]); w.w = pk2(v1[2], v1[3]);
                    *(u32x4*)(P + (size_t)r * NPROJ + pc) = w;
                    if (special) { float* dst = nullptr;
                        if (r < NPROMPT) { const int tpos = r & 2047, b = r >> 11;
                            if (pc < QKVD) { if (tpos >= 2045) dst = out + OUT_CP + ((size_t)(layer * 8 + b) * 3 + (tpos - 2045)) * QKVD + pc; }
                            else if (pc >= 2048) { if (tpos >= 2033) dst = out + OUT_PP + ((size_t)(layer * 8 + b) * 15 + (tpos - 2033)) * 512 + (pc - 2048); } }
                        else if (r < NVALID) { const int b = r - NPROMPT;
                            if (pc < QKVD) dst = out + OUT_CS + ((size_t)(layer * 128 + b) * 3 + 2) * QKVD + pc;
                            else if (pc >= 2048) dst = out + OUT_PS + ((size_t)(layer * 128 + b) * 15 + 14) * 512 + (pc - 2048); }
                        if (dst) { *(f32x4*)dst = v0; *(f32x4*)(dst + 4) = v1; } } }
                asm volatile("" ::: "memory"); }
    }
};

DI void prep_phase(LAS unsigned char* lds, const Args& a) {
    LAS bf16_t* tile = (LAS bf16_t*)lds;
    LAS unsigned* t32 = (LAS unsigned*)lds;
    int tid_ = threadIdx.x; asm volatile("" : "+v"(tid_));
    const int tid = tid_, c = tid & 255, kh = tid >> 8;
    const int it_lo = (int)(((long)blockIdx.x * (DEPTH * 1280)) / gridDim.x), it_hi = (int)(((long)(blockIdx.x + 1) * (DEPTH * 1280)) / gridDim.x);
    for (int it = it_lo; it < it_hi; ++it) {
        const int l = it / 1280; int r = it % 1280;
        const float* src0; const float* src1 = nullptr; int Nsrc, K, pn, kt, kind; size_t dsto;
        if (r < 352) { kind = 0; pn = r / 16; kt = r % 16; src0 = INP(a, 7) + (size_t)l * DM * FF; src1 = INP(a, 8) + (size_t)l * DM * FF; Nsrc = FF; K = DM; dsto = WO_GU1; }
        else if (r < 704) { r -= 352; kind = 0; pn = r / 16; kt = r % 16; src0 = INP(a, 20) + (size_t)l * DM * FF; src1 = INP(a, 21) + (size_t)l * DM * FF; Nsrc = FF; K = DM; dsto = WO_GU2; }
        else if (r < 880) { r -= 704; kind = 1; pn = r / 44; kt = r % 44; src0 = INP(a, 9) + (size_t)l * FF * DM; Nsrc = DM; K = FF; dsto = WO_D1; }
        else if (r < 1056) { r -= 880; kind = 1; pn = r / 44; kt = r % 44; src0 = INP(a, 22) + (size_t)l * FF * DM; Nsrc = DM; K = FF; dsto = WO_D2; }
        else if (r < 1216) { r -= 1056; kind = 2; pn = r / 16; kt = r % 16; src0 = INP(a, 10) + (size_t)l * DM * INDIM; Nsrc = INDIM; K = DM; dsto = WO_WIN; }
        else { r -= 1216; kind = 1; pn = r / 16; kt = r % 16; src0 = INP(a, 17) + (size_t)l * DM * DM; Nsrc = DM; K = DM; dsto = WO_WOUT; }
        const int w8 = tid >> 6, c4 = (tid & 63) * 4;
        const float* sp; int ldsrow;
        if (kind == 0) { const int which = c4 >> 7, hc = c4 & 127; sp = (which ? src1 : src0) + pn * 128 + hc; ldsrow = 128 * ((hc >> 2) & 1) + 32 * (hc >> 5) + 16 * which + 4 * ((hc >> 3) & 3) + (hc & 3); }
        else if (kind == 1) { sp = src0 + pn * 256 + c4; ldsrow = c4; }
        else { const int pc = pn * 256 + c4; sp = src0 + (pc < 2048 ? pc : pc + 8); ldsrow = 128 * (c4 >> 7) + 32 * ((c4 >> 5) & 3) + 16 * ((c4 >> 2) & 1) + 4 * ((c4 >> 3) & 3) + (c4 & 3); }
        const int k0 = kt * 64;
        sp += (size_t)(k0 + w8) * Nsrc;
        f32x4 tv[8];
#pragma unroll
        for (int it = 0; it < 8; ++it) tv[it] = __builtin_nontemporal_load((const f32x4*)(sp + (size_t)(8 * it) * Nsrc));
#pragma unroll
        for (int it = 0; it < 8; ++it)
#pragma unroll
            for (int j = 0; j < 4; ++j) tile[(ldsrow + j) * 66 + w8 + 8 * it] = f2bf(tv[it][j]);
        __syncthreads();
        unsigned* d32 = (unsigned*)(a.ws + WS_W + (size_t)l * W_LSTRIDE + dsto) + ((size_t)(pn * 256) * K + k0) / 2;
#pragma unroll
        for (int j = 0; j < 16; ++j) { const int idx = j * 512 + tid, row = idx >> 5, dw = idx & 31; d32[(size_t)row * (K / 2) + dw] = t32[row * 33 + dw]; }
        __syncthreads();
    }
    const size_t gt = (size_t)blockIdx.x * 512 + tid, gs = (size_t)gridDim.x * 512;
    for (size_t i = gt; i < (size_t)DEPTH * 4 * 128 * 128; i += gs) { const int d = (int)(i & 127), cc = (int)((i >> 7) & 127); const size_t lg = i >> 14; const int l = (int)(lg >> 2), g = (int)(lg & 3);
        ((bf16_t*)(a.ws + WS_W + (size_t)l * W_LSTRIDE + WO_PW))[(size_t)(g * 128 + d) * 128 + cc] = f2bf(INP(a, 15)[i]); }
    { float* R = (float*)(a.ws + WS_R); bf16_t* XB = (bf16_t*)(a.ws + WS_XB);
      for (size_t i = gt; i < (size_t)ROWS * 256; i += gs) { const size_t row = i >> 8; const int c4 = (int)(i & 255) * 4; f32x4 v = {0.f, 0.f, 0.f, 0.f};
          if (row < NPROMPT) v = *(const f32x4*)(INP(a, 0) + row * DM + c4); else if (row < NVALID) v = *(const f32x4*)(INP(a, 1) + (row - NPROMPT) * DM + c4);
          *(f32x4*)(R + row * DM + c4) = v * ALPHA; u32x2 w; w.x = pk2(v[0], v[1]); w.y = pk2(v[2], v[3]); *(u32x2*)(XB + row * DM + c4) = w; } }
    for (size_t i = gt; i < (size_t)DEPTH * 128 * 2 * QKVD; i += gs) { const size_t lb = i / (2 * QKVD), rem = i % (2 * QKVD); a.out[OUT_CS + lb * 3 * QKVD + rem] = INP(a, 3)[lb * 3 * QKVD + QKVD + rem]; }
    for (size_t i = gt; i < (size_t)DEPTH * 128 * 14 * 512; i += gs) { const size_t lb = i / (14 * 512), rem = i % (14 * 512); a.out[OUT_PS + lb * 15 * 512 + rem] = INP(a, 4)[lb * 15 * 512 + 512 + rem]; }
}

DI void ln_phase(LAS unsigned char* lds, const Args& a, int l, int mode) {
    int tid_ = threadIdx.x; asm volatile("" : "+v"(tid_));
    const int tid = tid_, wave = tid >> 6, lane = tid & 63;
    float* R = (float*)(a.ws + WS_R); bf16_t* XB = (bf16_t*)(a.ws + WS_XB);
    const float* gam = INP(a, mode == 1 ? 5 : (mode == 2 ? 18 : 23)) + l * DM;
    const float* bet = INP(a, mode == 1 ? 6 : (mode == 2 ? 19 : 24)) + l * DM;
    LAS float* w8s = (LAS float*)lds;
    if (mode == 1) { const float* win = INP(a, 10) + (size_t)l * DM * INDIM + 2048;
        for (int i = tid; i < 8192; i += 512) { const int k = i >> 3, c = i & 7; w8s[c * 1024 + k] = win[(size_t)k * INDIM + c]; }
        __syncthreads(); }
    f32x4 g4[4], b4[4];
#pragma unroll
    for (int i = 0; i < 4; ++i) { g4[i] = *(const f32x4*)(gam + 256 * i + 4 * lane); b4[i] = *(const f32x4*)(bet + 256 * i + 4 * lane); }
    float alog = 0.f, dtb = 0.f;
    if (mode == 1) { alog = INP(a, 12)[l * 4 + (lane & 3)]; dtb = INP(a, 13)[l * 4 + (lane & 3)]; }
    const bool wy = (mode == 3 && l == DEPTH - 1);
    f32x4 xn[4];
    { const int row = blockIdx.x * 8 + wave; if (row < ROWS) {
#pragma unroll
        for (int i = 0; i < 4; ++i) xn[i] = *(const f32x4*)(R + (size_t)row * DM + 256 * i + 4 * lane); } }
    for (int row = blockIdx.x * 8 + wave; row < ROWS; row += gridDim.x * 8) {
        float* rp = R + (size_t)row * DM;
        f32x4 x[4];
#pragma unroll
        for (int i = 0; i < 4; ++i) x[i] = xn[i];
        { const int nrow = row + gridDim.x * 8; if (nrow < ROWS) {
#pragma unroll
            for (int i = 0; i < 4; ++i) xn[i] = *(const f32x4*)(R + (size_t)nrow * DM + 256 * i + 4 * lane); } }
        if (row >= NPROMPT) { const int np = (mode == 2) ? 4 : 11; const float* pp = (const float*)(a.ws + WS_PART) + (size_t)(row - NPROMPT) * DM + 4 * lane;
#pragma unroll
            for (int i = 0; i < 4; ++i) { const u32x2 hb = *(const u32x2*)(XB + (size_t)row * DM + 256 * i + 4 * lane); x[i] = (f32x4){bflo(hb.x), bfhi(hb.x), bflo(hb.y), bfhi(hb.y)} * ALPHA; }
            for (int p = 0; p < np; ++p) {
#pragma unroll
                for (int i = 0; i < 4; ++i) x[i] += *(const f32x4*)(pp + (size_t)p * 256 * DM + 256 * i); } }
        float s = 0.f;
#pragma unroll
        for (int i = 0; i < 4; ++i) s += (x[i][0] + x[i][1]) + (x[i][2] + x[i][3]);
        const float mean = wave_sum(s) * (1.f / 1024.f);
        float q = 0.f;
#pragma unroll
        for (int i = 0; i < 4; ++i) { x[i] = x[i] - mean; q += (x[i][0] * x[i][0] + x[i][1] * x[i][1]) + (x[i][2] * x[i][2] + x[i][3] * x[i][3]); }
        const float rstd = rsqrtf(wave_sum(q) * (1.f / 1024.f) + 1e-5f);
#pragma unroll
        for (int i = 0; i < 4; ++i) { x[i] = x[i] * rstd * g4[i] + b4[i];
            u32x2 w; w.x = pk2(x[i][0], x[i][1]); w.y = pk2(x[i][2], x[i][3]); *(u32x2*)(XB + (size_t)row * DM + 256 * i + 4 * lane) = w; }
        if (wy) { if (row < NPROMPT) { float* yp = a.out + OUT_YP + (size_t)row * DM;
#pragma unroll
                for (int i = 0; i < 4; ++i) *(f32x4*)(yp + 256 * i + 4 * lane) = x[i]; }
            else if (row < NVALID) { float* yp = a.out + OUT_YS + (size_t)(row - NPROMPT) * DM;
#pragma unroll
                for (int i = 0; i < 4; ++i) *(f32x4*)(yp + 256 * i + 4 * lane) = x[i]; } }
        if (mode == 1) {
            float d0 = 0.f, d1 = 0.f, d2 = 0.f, d3 = 0.f, d4 = 0.f, d5 = 0.f, d6 = 0.f, d7 = 0.f;
#pragma unroll
            for (int i = 0; i < 4; ++i) { const int ko = 256 * i + 4 * lane; f32x4 w;
                w = *(const LAS f32x4*)(w8s + 0 * 1024 + ko); d0 += (x[i][0] * w[0] + x[i][1] * w[1]) + (x[i][2] * w[2] + x[i][3] * w[3]);
                w = *(const LAS f32x4*)(w8s + 1 * 1024 + ko); d1 += (x[i][0] * w[0] + x[i][1] * w[1]) + (x[i][2] * w[2] + x[i][3] * w[3]);
                w = *(const LAS f32x4*)(w8s + 2 * 1024 + ko); d2 += (x[i][0] * w[0] + x[i][1] * w[1]) + (x[i][2] * w[2] + x[i][3] * w[3]);
                w = *(const LAS f32x4*)(w8s + 3 * 1024 + ko); d3 += (x[i][0] * w[0] + x[i][1] * w[1]) + (x[i][2] * w[2] + x[i][3] * w[3]);
                w = *(const LAS f32x4*)(w8s + 4 * 1024 + ko); d4 += (x[i][0] * w[0] + x[i][1] * w[1]) + (x[i][2] * w[2] + x[i][3] * w[3]);
                w = *(const LAS f32x4*)(w8s + 5 * 1024 + ko); d5 += (x[i][0] * w[0] + x[i][1] * w[1]) + (x[i][2] * w[2] + x[i][3] * w[3]);
                w = *(const LAS f32x4*)(w8s + 6 * 1024 + ko); d6 += (x[i][0] * w[0] + x[i][1] * w[1]) + (x[i][2] * w[2] + x[i][3] * w[3]);
                w = *(const LAS f32x4*)(w8s + 7 * 1024 + ko); d7 += (x[i][0] * w[0] + x[i][1] * w[1]) + (x[i][2] * w[2] + x[i][3] * w[3]); }
            d0 = wave_sum(d0); d1 = wave_sum(d1); d2 = wave_sum(d2); d3 = wave_sum(d3); d4 = wave_sum(d4); d5 = wave_sum(d5); d6 = wave_sum(d6); d7 = wave_sum(d7);
            if (lane < 4) { const float braw = lane == 0 ? d0 : (lane == 1 ? d1 : (lane == 2 ? d2 : d3)); const float araw = lane == 0 ? d4 : (lane == 1 ? d5 : (lane == 2 ? d6 : d7));
                const float xx = araw + dtb; const float sp = xx > 20.f ? xx : log1pf(expf(xx));
                ((float*)(a.ws + WS_BETA))[(size_t)row * 4 + lane] = 1.f / (1.f + expf(-braw));
                ((float*)(a.ws + WS_G))[(size_t)row * 4 + lane] = -expf(alog) * sp; }
        }
    }
}

struct SolveCtx { const LAS float* Mm; const LAS float* betas; const LAS float* egs; const LAS bf16_t* colp; float* UVs; bf16_t* WKs; bool isv; };
template <int I>
DI void solve_row(const SolveCtx& c, f32x2 (&xp)[32], f32x4 (&lc)[8], f32x4 (&ln)[8], float bcur, float ecur, bf16_t ccur) {
    float bnx = 0.f, enx = 0.f; bf16_t cnx = 0;
    if constexpr (I + 1 < 64) {
#pragma unroll
        for (int q = 0; q < 8; ++q) if (4 * q < I + 1) ln[q] = *(const LAS f32x4*)(c.Mm + (I + 1) * 64 + 4 * q);
        bnx = c.betas[I + 1]; enx = c.egs[I + 1]; cnx = c.colp[(I + 1) * 136]; }
    __builtin_amdgcn_sched_barrier(0);
    float sc = bcur; if (!c.isv) sc *= ecur;
    f32x2 a01 = {sc * bf2f(ccur), 0.f}, a23 = {0.f, 0.f};
#pragma unroll
    for (int q = 0; q < 16; ++q) if (4 * q < I) { f32x4 mv; if (q < 8) mv = lc[q < 8 ? q : 0]; else mv = *(const LAS f32x4*)(c.Mm + I * 64 + 4 * q);
        if (4 * q + 1 < I) a01 -= (f32x2){mv[0], mv[1]} * xp[2 * q]; else a01[0] -= mv[0] * xp[2 * q][0];
        if (4 * q + 3 < I) a23 -= (f32x2){mv[2], mv[3]} * xp[2 * q + 1]; else if (4 * q + 2 < I) a23[0] -= mv[2] * xp[2 * q + 1][0]; }
    const float xi = (a01[0] + a01[1]) + (a23[0] + a23[1]);
    xp[I >> 1][I & 1] = xi;
    if (c.isv) { if constexpr ((I & 3) == 3) *(f32x4*)(c.UVs + (size_t)((I >> 4) * 64 + ((I >> 2) & 3) * 16) * 4) = (f32x4){xp[(I >> 1) - 1][0], xp[(I >> 1) - 1][1], xp[I >> 1][0], xi}; }
    else c.WKs[I * 128] = f2bf(xi);
    __builtin_amdgcn_sched_barrier(0);
    if constexpr (I + 1 < 64) solve_row<I + 1>(c, xp, ln, lc, bnx, enx, cnx);
}

DI void dprep_item(LAS unsigned char* ldsh, const Args& a, int l, int item, int tl) {
    const int n = item & 31, h = (item >> 5) & 3, b = item >> 7;
    const int r0 = b * 2048 + n * 64;
    LAS bf16_t* qn = (LAS bf16_t*)ldsh; LAS bf16_t* kn = qn + 64 * 136; LAS bf16_t* vv = kn + 64 * 136;
    LAS float* Mm = (LAS float*)(ldsh + 3 * 17408);
    LAS float* gcs = (LAS float*)(ldsh + 3 * 17408 + 16384); LAS float* betas = gcs + 64; LAS float* egs = gcs + 128;
    const bf16_t* PROJ = (const bf16_t*)(a.ws + WS_HID);
    const float* BETA = (const float*)(a.ws + WS_BETA); const float* G = (const float*)(a.ws + WS_G);
    { const int cg4 = tl & 31, rg = tl >> 5, c0 = cg4 * 4;
      for (int sec = 0; sec < 3; ++sec) {
          const int col = sec * 512 + h * 128 + c0;
          f32x4 w[4];
#pragma unroll
          for (int i = 0; i < 4; ++i) w[i] = *(const f32x4*)(INP(a, 11) + (size_t)(l * 4 + i) * QKVD + col);
          f32x4 xin[11];
#pragma unroll
          for (int i = 0; i < 11; ++i) { const int tpos = n * 64 + rg * 8 - 3 + i;
              if (tpos >= 0) { const u32x2 raw = *(const u32x2*)(PROJ + (size_t)(r0 + rg * 8 - 3 + i) * NPROJ + col); xin[i] = (f32x4){bflo(raw.x), bfhi(raw.x), bflo(raw.y), bfhi(raw.y)}; }
              else xin[i] = (f32x4){0.f, 0.f, 0.f, 0.f}; }
          LAS bf16_t* dst = sec == 0 ? qn : (sec == 1 ? kn : vv);
#pragma unroll
          for (int j = 0; j < 8; ++j) { f32x4 o = w[0] * xin[j] + w[1] * xin[j + 1] + w[2] * xin[j + 2] + w[3] * xin[j + 3];
              o[0] = silu_f(o[0]); o[1] = silu_f(o[1]); o[2] = silu_f(o[2]); o[3] = silu_f(o[3]);
              if (sec < 2) { float ss = (o[0] * o[0] + o[1] * o[1]) + (o[2] * o[2] + o[3] * o[3]);
                  ss += __shfl_xor(ss, 16); ss += __shfl_xor(ss, 8); ss += __shfl_xor(ss, 4); ss += __shfl_xor(ss, 2); ss += __shfl_xor(ss, 1);
                  const float sc = rsqrtf(ss + 1e-6f) * (sec == 0 ? 0.08838834764831845f : 1.f); o = o * sc; }
              u32x2 pw; pw.x = pk2(o[0], o[1]); pw.y = pk2(o[2], o[3]); *(LAS u32x2*)(dst + (rg * 8 + j) * 136 + c0) = pw; }
      } }
    if (tl < 64) { float g = G[(size_t)(r0 + tl) * 4 + h];
#pragma unroll
        for (int o = 1; o < 64; o <<= 1) { const float t = __shfl_up(g, o); if (tl >= o) g += t; }
        gcs[tl] = g; betas[tl] = BETA[(size_t)(r0 + tl) * 4 + h]; const float eg = expf(g); egs[tl] = eg;
        egs[64 + tl] = __expf(__shfl(g, 63) - g);
        if (tl == 63) ((float*)(a.ws + WS_GE))[item] = eg; }
    __syncthreads();
    { const int wl = tl >> 6, lane = tl & 63, fr = lane & 15, fq = lane >> 4;
      bf16x8 ak[4], aq[4];
#pragma unroll
      for (int ks = 0; ks < 4; ++ks) { ak[ks] = *(const LAS bf16x8*)(kn + (16 * wl + fr) * 136 + 32 * ks + 8 * fq); aq[ks] = *(const LAS bf16x8*)(qn + (16 * wl + fr) * 136 + 32 * ks + 8 * fq); }
      bf16_t* QKs = (bf16_t*)(a.ws + WS_QK) + (size_t)item * 4096;
#pragma unroll
      for (int nt = 0; nt < 4; ++nt) { f32x4 ckk = {0.f, 0.f, 0.f, 0.f}, cqk = {0.f, 0.f, 0.f, 0.f};
#pragma unroll
          for (int ks = 0; ks < 4; ++ks) { const bf16x8 bb = *(const LAS bf16x8*)(kn + (16 * nt + fr) * 136 + 32 * ks + 8 * fq); ckk = MFMA16(ak[ks], bb, ckk); cqk = MFMA16(aq[ks], bb, cqk); }
          const int j = 16 * nt + fr; const float gj = gcs[j]; const int pj = perm6(j);
#pragma unroll
          for (int reg = 0; reg < 4; ++reg) { const int t = 16 * wl + 4 * fq + reg; const float dec = (j <= t) ? __expf(gcs[t] - gj) : 0.f;
              if (j < t) Mm[t * 64 + j] = betas[t] * ckk[reg] * dec;
              QKs[t * 64 + pj] = f2bf(cqk[reg] * dec); } }
      bf16_t* QDs = (bf16_t*)(a.ws + WS_QD) + (size_t)item * 8192;
      for (int e = tl; e < 1024; e += 256) { const int t = e >> 4, grp = e & 15, ks = grp >> 2, f2 = grp & 3; const float eg = egs[t];
          const u32x2 x0 = *(const LAS u32x2*)(qn + t * 136 + 32 * ks + 4 * f2), x1 = *(const LAS u32x2*)(qn + t * 136 + 32 * ks + 16 + 4 * f2);
          u32x4 w; w.x = pk2(bflo(x0.x) * eg, bfhi(x0.x) * eg); w.y = pk2(bflo(x0.y) * eg, bfhi(x0.y) * eg); w.z = pk2(bflo(x1.x) * eg, bfhi(x1.x) * eg); w.w = pk2(bflo(x1.y) * eg, bfhi(x1.y) * eg);
          *(u32x4*)(QDs + t * 128 + 32 * ks + 8 * f2) = w; }
      bf16_t* KETs = (bf16_t*)(a.ws + WS_KET) + (size_t)item * 8192; const float g63 = gcs[63];
      for (int e = tl; e < 1024; e += 256) { const int dk = e & 127, grp = e >> 7, ks = grp >> 2, f2 = grp & 3; float v[8];
#pragma unroll
          for (int i = 0; i < 8; ++i) { const int t = 32 * ks + 16 * (i >> 2) + 4 * f2 + (i & 3); v[i] = bf2f(kn[t * 136 + dk]) * egs[64 + t]; }
          u32x4 w; w.x = pk2(v[0], v[1]); w.y = pk2(v[2], v[3]); w.z = pk2(v[4], v[5]); w.w = pk2(v[6], v[7]);
          *(u32x4*)(KETs + dk * 64 + 32 * ks + 8 * f2) = w; }
    }
    __syncthreads();
    { const int c = tl; const bool isv = c < 128; const LAS bf16_t* colp = isv ? (vv + c) : (kn + (c - 128));
      float* UVs = (float*)(a.ws + WS_UV) + (size_t)item * 8192 + (size_t)(((c >> 4) & 7) * 4 * 64 + (c & 15)) * 4;
      bf16_t* WKs = (bf16_t*)(a.ws + WS_WK) + (size_t)item * 8192 + perm7(c & 127);
      f32x2 xp[32]; f32x4 mA[8], mB[8];
      SolveCtx sc_{Mm, betas, egs, colp, UVs, WKs, isv};
      mA[0] = *(const LAS f32x4*)(Mm + 64);
      { float sc = betas[0]; if (!isv) sc *= egs[0]; const float x0 = sc * bf2f(colp[0]); xp[0][0] = x0; if (!isv) WKs[0] = f2bf(x0); }
      solve_row<1>(sc_, xp, mA, mB, betas[1], egs[1], colp[136]);
    }
    __syncthreads();
}

DI void sample_item(LAS unsigned char* lds, const Args& a, int l, int item) {
    int tid_ = threadIdx.x; asm volatile("" : "+v"(tid_));
    const int tid = tid_, h = item & 3, b = item >> 2, row = NPROMPT + b;
    LAS float* vals = (LAS float*)lds;
    LAS float* red3 = vals + 384;
    LAS float* red = vals + 512;
    const bf16_t* PROJ = (const bf16_t*)(a.ws + WS_HID);
    float myv = 0.f;
    if (tid < 384) { const int sec = tid >> 7, c = tid & 127, col = sec * 512 + h * 128 + c;
        const float x0 = bf2f(PROJ[(size_t)row * NPROJ + col]);
        const float* sc = INP(a, 3) + (size_t)(l * 128 + b) * 3 * QKVD + col; const float* cw = INP(a, 11) + (size_t)l * 4 * QKVD + col;
        myv = silu_f(cw[0] * sc[0] + cw[QKVD] * sc[QKVD] + cw[2 * QKVD] * sc[2 * QKVD] + cw[3 * QKVD] * x0);
        vals[tid] = myv; }
    __syncthreads();
    if (tid < 192) { const int w = tid >> 6, lane = tid & 63; float s;
        if (w == 0) s = vals[lane] * vals[lane] + vals[lane + 64] * vals[lane + 64];
        else if (w == 1) s = vals[128 + lane] * vals[128 + lane] + vals[192 + lane] * vals[192 + lane];
        else s = vals[lane] * vals[128 + lane] + vals[lane + 64] * vals[192 + lane];
        s = wave_sum(s); if (lane == 0) red3[w] = s; }
    __syncthreads();
    const float qsc = rsqrtf(red3[0] + 1e-6f) * 0.08838834764831845f, ksc = rsqrtf(red3[1] + 1e-6f), qkdot = red3[2] * qsc * ksc;
    const float beta = ((const float*)(a.ws + WS_BETA))[(size_t)row * 4 + h], ga = expf(((const float*)(a.ws + WS_G))[(size_t)row * 4 + h]);
    const int dv4 = tid & 31, dkg = tid >> 5;
    const float* S0 = INP(a, 2) + (size_t)((l * 128 + b) * 4 + h) * 16384;
    f32x4 S[8]; f32x4 ks4 = {0.f, 0.f, 0.f, 0.f}, qs4 = {0.f, 0.f, 0.f, 0.f};
#pragma unroll
    for (int j = 0; j < 8; ++j) { const int dk = dkg * 8 + j; S[j] = __builtin_nontemporal_load((const f32x4*)(S0 + dk * 128 + dv4 * 4)); const float kk = vals[128 + dk] * ksc, qq = vals[dk] * qsc; ks4 += S[j] * kk; qs4 += S[j] * qq; }
    *(LAS f32x4*)(red + (dkg * 128 + dv4 * 4) * 2) = ks4; *(LAS f32x4*)(red + (dkg * 128 + dv4 * 4) * 2 + 4) = qs4;
    __syncthreads();
    f32x4 kS = {0.f, 0.f, 0.f, 0.f}, qS = {0.f, 0.f, 0.f, 0.f};
#pragma unroll
    for (int g = 0; g < 16; ++g) { kS += *(const LAS f32x4*)(red + (g * 128 + dv4 * 4) * 2); qS += *(const LAS f32x4*)(red + (g * 128 + dv4 * 4) * 2 + 4); }
    f32x4 v4 = *(const LAS f32x4*)(vals + 256 + dv4 * 4);
    const f32x4 u = v4 * beta - kS * (beta * ga);
    float* Sout = a.out + OUT_DS + (size_t)((l * 128 + b) * 4 + h) * 16384;
#pragma unroll
    for (int j = 0; j < 8; ++j) { const int dk = dkg * 8 + j; const float kk = vals[128 + dk] * ksc; __builtin_nontemporal_store(S[j] * ga + u * kk, (f32x4*)(Sout + dk * 128 + dv4 * 4)); }
    if (dkg == 0) { const f32x4 o = qS * ga + u * qkdot; *(f32x4*)((float*)(a.ws + WS_O) + (size_t)row * 512 + h * 128 + dv4 * 4) = o; }
    __syncthreads();
}

template <int W>
DI void pool_fill(LAS bf16_t* dA, const Args& a, int l, int g, int t0, int tid) {
    const bf16_t* PROJ = (const bf16_t*)(a.ws + WS_HID);
    const int c0 = (tid & 31) * 4, rg = tid >> 5, lr0 = rg * 8, row0 = t0 + lr0;
    if (t0 < NPROMPT) {
        const int tpos0 = row0 & 2047;
        const bf16_t* pp = PROJ + (size_t)row0 * NPROJ + 2048 + g * 128 + c0;
        f32x4 pv[W + 7];
#pragma unroll
        for (int i = 0; i < W + 7; ++i) { const int dr = i - (W - 1);
            if (tpos0 + dr >= 0) { const u32x2 rw = *(const u32x2*)(pp + (long)dr * NPROJ); pv[i] = (f32x4){bflo(rw.x), bfhi(rw.x), bflo(rw.y), bfhi(rw.y)}; }
            else pv[i] = (f32x4){0.f, 0.f, 0.f, 0.f}; }
#pragma unroll
        for (int j = 0; j < 8; ++j) { f32x4 sum = pv[j];
#pragma unroll
            for (int i = 1; i < W; ++i) sum += pv[j + i];
            const int tp = tpos0 + j; const float inv = __builtin_amdgcn_rcpf((float)((tp + 1 < W) ? tp + 1 : W));
            const f32x4 d = sum * inv - pv[j + W - 1]; u32x2 pw; pw.x = pk2(d[0], d[1]); pw.y = pk2(d[2], d[3]); *(LAS u32x2*)(dA + (lr0 + j) * 136 + c0) = pw; }
    } else {
#pragma unroll
        for (int j = 0; j < 8; ++j) { const int row = row0 + j; const bf16_t* pp = PROJ + (size_t)row * NPROJ + 2048 + g * 128 + c0;
            const u32x2 raw = *(const u32x2*)pp; const f32x4 p0 = {bflo(raw.x), bfhi(raw.x), bflo(raw.y), bfhi(raw.y)}; f32x4 sum = p0;
            const float* sp = INP(a, 4) + (size_t)(l * 128 + (row - NPROMPT)) * 15 * 512 + g * 128 + c0;
#pragma unroll
            for (int i = 1; i < W; ++i) sum += *(const f32x4*)(sp + (size_t)(15 - i) * 512);
            const f32x4 d = sum * (1.f / (float)W) - p0; u32x2 pw; pw.x = pk2(d[0], d[1]); pw.y = pk2(d[2], d[3]); *(LAS u32x2*)(dA + (lr0 + j) * 136 + c0) = pw; }
    }
}
DI void pool_item(LAS unsigned char* lds, const Args& a, int l, int item) {
    int tid_ = threadIdx.x; asm volatile("" : "+v"(tid_));
    const int tid = tid_, g = item & 3, rt = item >> 2, t0 = rt * 128;
    LAS bf16_t* dA = (LAS bf16_t*)lds; LAS bf16_t* wB = dA + 128 * 136;
    const bf16_t* PW = (const bf16_t*)(a.ws + WS_W + (size_t)l * W_LSTRIDE + WO_PW) + (size_t)g * 16384;
    for (int e = tid; e < 2048; e += 512) { const int r = e >> 4, c8 = (e & 15) * 8; *(LAS u32x4*)(wB + r * 136 + c8) = *(const u32x4*)(PW + r * 128 + c8); }
    if (g == 0) pool_fill<2>(dA, a, l, g, t0, tid); else if (g == 1) pool_fill<4>(dA, a, l, g, t0, tid); else if (g == 2) pool_fill<8>(dA, a, l, g, t0, tid); else pool_fill<16>(dA, a, l, g, t0, tid);
    __syncthreads();
    { const int w8 = tid >> 6, lane = tid & 63, fr = lane & 15, fq = lane >> 4;
      bf16x8 af[4];
#pragma unroll
      for (int ks = 0; ks < 4; ++ks) af[ks] = *(const LAS bf16x8*)(dA + (16 * w8 + fr) * 136 + 32 * ks + 8 * fq);
      bf16_t* MIX = (bf16_t*)(a.ws + WS_MIX); const float* psc = INP(a, 16) + l * 512 + g * 128;
#pragma unroll
      for (int nt = 0; nt < 8; ++nt) { f32x4 acc = {0.f, 0.f, 0.f, 0.f};
#pragma unroll
          for (int ks = 0; ks < 4; ++ks) { const bf16x8 bb = *(const LAS bf16x8*)(wB + (16 * nt + fr) * 136 + 32 * ks + 8 * fq); acc = MFMA16(af[ks], bb, acc); }
          const int col = 16 * nt + fr; const float sc = psc[col];
#pragma unroll
          for (int reg = 0; reg < 4; ++reg) MIX[(size_t)(t0 + 16 * w8 + 4 * fq + reg) * DM + 512 + g * 128 + col] = f2bf(acc[reg] * sc); } }
    __syncthreads();
}

DI void scan_phase(LAS unsigned char* lds, const Args& a, int l) {
    int tid_ = threadIdx.x; asm volatile("" : "+v"(tid_));
    const int tid = tid_, s = tid >> 6, lane = tid & 63, fr = lane & 15, fq = lane >> 4;
    constexpr int BUF = 62464, O_WK = 0, O_QD = 17408, O_KET = 34816, O_QK = 53248;
    const int lw0 = (tid >> 4) * 272 + (tid & 15) * 16, lw1 = ((tid + 512) >> 4) * 272 + (tid & 15) * 16;
    const int lk0 = (tid >> 3) * 144 + (tid & 7) * 16, lk1 = ((tid + 512) >> 3) * 144 + (tid & 7) * 16;
#define SC_LOADG(it_) do { const unsigned char* _w = a.ws + WS_WK + (size_t)(it_) * 16384 + tid * 16; const unsigned char* _q = a.ws + WS_QD + (size_t)(it_) * 16384 + tid * 16; \
        const unsigned char* _k = a.ws + WS_KET + (size_t)(it_) * 16384 + tid * 16; \
        pf[0] = *(const u32x4*)_w; pf[1] = *(const u32x4*)(_w + 8192); pf[2] = *(const u32x4*)_q; pf[3] = *(const u32x4*)(_q + 8192); \
        pf[4] = *(const u32x4*)_k; pf[5] = *(const u32x4*)(_k + 8192); pf[6] = *(const u32x4*)(a.ws + WS_QK + (size_t)(it_) * 8192 + tid * 16); \
        } while (0)
#define SC_LOADUV(it_) do { const float* _u = (const float*)(a.ws + WS_UV) + (size_t)(it_) * 8192 + s * 1024 + lane * 4; \
        uvn[0] = *(const f32x4*)_u; uvn[1] = *(const f32x4*)(_u + 256); uvn[2] = *(const f32x4*)(_u + 512); uvn[3] = *(const f32x4*)(_u + 768); \
        gen = ((const float*)(a.ws + WS_GE))[(it_)]; } while (0)
#define SC_STORE(bo_) do { LAS unsigned char* _b = lds + (bo_); \
        *(LAS u32x4*)(_b + O_WK + lw0) = pf[0]; *(LAS u32x4*)(_b + O_WK + lw1) = pf[1]; *(LAS u32x4*)(_b + O_QD + lw0) = pf[2]; *(LAS u32x4*)(_b + O_QD + lw1) = pf[3]; \
        *(LAS u32x4*)(_b + O_KET + lk0) = pf[4]; *(LAS u32x4*)(_b + O_KET + lk1) = pf[5]; *(LAS u32x4*)(_b + O_QK + lk0) = pf[6]; } while (0)
    for (int bh = blockIdx.x; bh < 32; bh += gridDim.x) {
        const int b = bh >> 2, h = bh & 3;
        const size_t item0 = (size_t)bh * 32;
        f32x4 S[8]; bf16x8 Sb[4];
#pragma unroll
        for (int i = 0; i < 8; ++i) S[i] = (f32x4){0.f, 0.f, 0.f, 0.f};
#pragma unroll
        for (int i = 0; i < 4; ++i) Sb[i] = (bf16x8){0, 0, 0, 0, 0, 0, 0, 0};
        u32x4 pf[7]; f32x4 uvn[4], uvc[4]; float gen, gec;
        SC_LOADG(item0); SC_LOADUV(item0);
        SC_STORE(0);
#pragma unroll
        for (int m = 0; m < 4; ++m) uvc[m] = uvn[m];
        gec = gen;
        SC_LOADG(item0 + 1);
        __syncthreads();
        float* O = (float*)(a.ws + WS_O);
        for (int n = 0; n < 32; ++n) {
            const int cur = (n & 1) * BUF;
            if (n + 1 < 32) { SC_STORE(BUF - cur); SC_LOADUV(item0 + n + 1); }
            if (n + 2 < 32) SC_LOADG(item0 + n + 2);
            const LAS unsigned char* B = lds + cur;
            f32x4 ws[4], o[4];
#pragma unroll
            for (int m = 0; m < 4; ++m) { ws[m] = (f32x4){0.f, 0.f, 0.f, 0.f}; o[m] = (f32x4){0.f, 0.f, 0.f, 0.f}; }
#pragma unroll
            for (int ks = 0; ks < 4; ++ks)
#pragma unroll
                for (int m = 0; m < 4; ++m) { const bf16x8 av = *(const LAS bf16x8*)(B + O_WK + (16 * m + fr) * 272 + (32 * ks + 8 * fq) * 2); ws[m] = MFMA16(av, Sb[ks], ws[m]); }
#pragma unroll
            for (int ks = 0; ks < 4; ++ks)
#pragma unroll
                for (int m = 0; m < 4; ++m) { const bf16x8 av = *(const LAS bf16x8*)(B + O_QD + (16 * m + fr) * 272 + (32 * ks + 8 * fq) * 2); o[m] = MFMA16(av, Sb[ks], o[m]); }
            f32x4 u[4];
#pragma unroll
            for (int m = 0; m < 4; ++m) u[m] = uvc[m] - ws[m];
            bf16x8 Ub[2]; Ub[0] = pack8(u[0], u[1]); Ub[1] = pack8(u[2], u[3]);
#pragma unroll
            for (int ks = 0; ks < 2; ++ks)
#pragma unroll
                for (int m = 0; m < 4; ++m) { const bf16x8 av = *(const LAS bf16x8*)(B + O_QK + (16 * m + fr) * 144 + (32 * ks + 8 * fq) * 2); o[m] = MFMA16(av, Ub[ks], o[m]); }
#pragma unroll
            for (int mt = 0; mt < 8; ++mt) S[mt] = S[mt] * gec;
#pragma unroll
            for (int ks = 0; ks < 2; ++ks)
#pragma unroll
                for (int mt = 0; mt < 8; ++mt) { const bf16x8 av = *(const LAS bf16x8*)(B + O_KET + (16 * mt + fr) * 144 + (32 * ks + 8 * fq) * 2); S[mt] = MFMA16(av, Ub[ks], S[mt]); }
#pragma unroll
            for (int ks = 0; ks < 4; ++ks) Sb[ks] = pack8(S[2 * ks], S[2 * ks + 1]);
            float* op = O + (size_t)(b * 2048 + n * 64 + 4 * fq) * 512 + h * 128 + 16 * s + fr;
#pragma unroll
            for (int m = 0; m < 4; ++m)
#pragma unroll
                for (int reg = 0; reg < 4; ++reg) op[(size_t)(16 * m + reg) * 512] = o[m][reg];
#pragma unroll
            for (int m = 0; m < 4; ++m) uvc[m] = uvn[m];
            gec = gen;
            __syncthreads();
        }
        float* dp = a.out + OUT_DP + (size_t)((l * 8 + b) * 4 + h) * 16384 + (size_t)(4 * fq) * 128 + 16 * s + fr;
#pragma unroll
        for (int mt = 0; mt < 8; ++mt)
#pragma unroll
            for (int reg = 0; reg < 4; ++reg) dp[(size_t)(16 * mt + reg) * 128] = S[mt][reg];
    }
#undef SC_LOADG
#undef SC_LOADUV
#undef SC_STORE
}

DI void gate_phase(const Args& a, int l) {
    int tid_ = threadIdx.x; asm volatile("" : "+v"(tid_));
    const int tid = tid_, wave = tid >> 6, lane = tid & 63;
    const float* O = (const float*)(a.ws + WS_O); const bf16_t* PROJ = (const bf16_t*)(a.ws + WS_HID); bf16_t* MIX = (bf16_t*)(a.ws + WS_MIX);
    const float* og = INP(a, 14) + l * 128 + (lane & 15) * 8;
    const f32x4 g0 = *(const f32x4*)og, g1 = *(const f32x4*)(og + 4);
    f32x4 n0 = {0.f, 0.f, 0.f, 0.f}, n1 = {0.f, 0.f, 0.f, 0.f}; u32x4 nz = {0u, 0u, 0u, 0u};
    { const int row = blockIdx.x * 8 + wave; if (row < NVALID) { n0 = *(const f32x4*)(O + (size_t)row * 512 + lane * 8); n1 = *(const f32x4*)(O + (size_t)row * 512 + lane * 8 + 4); nz = *(const u32x4*)(PROJ + (size_t)row * NPROJ + 1536 + lane * 8); } }
    for (int row = blockIdx.x * 8 + wave; row < NVALID; row += gridDim.x * 8) {
        const f32x4 o0 = n0, o1 = n1; const u32x4 zr = nz;
        { const int nrow = row + gridDim.x * 8; if (nrow < NVALID) { n0 = *(const f32x4*)(O + (size_t)nrow * 512 + lane * 8); n1 = *(const f32x4*)(O + (size_t)nrow * 512 + lane * 8 + 4); nz = *(const u32x4*)(PROJ + (size_t)nrow * NPROJ + 1536 + lane * 8); } }
        float ss = (o0[0] * o0[0] + o0[1] * o0[1]) + (o0[2] * o0[2] + o0[3] * o0[3]) + (o1[0] * o1[0] + o1[1] * o1[1]) + (o1[2] * o1[2] + o1[3] * o1[3]);
        ss += __shfl_xor(ss, 8); ss += __shfl_xor(ss, 4); ss += __shfl_xor(ss, 2); ss += __shfl_xor(ss, 1);
        const float rs = rsqrtf(ss * (1.f / 128.f) + 1e-6f);
        float r[8];
        r[0] = o0[0] * rs * g0[0] * silu_f(bflo(zr.x)); r[1] = o0[1] * rs * g0[1] * silu_f(bfhi(zr.x));
        r[2] = o0[2] * rs * g0[2] * silu_f(bflo(zr.y)); r[3] = o0[3] * rs * g0[3] * silu_f(bfhi(zr.y));
        r[4] = o1[0] * rs * g1[0] * silu_f(bflo(zr.z)); r[5] = o1[1] * rs * g1[1] * silu_f(bfhi(zr.z));
        r[6] = o1[2] * rs * g1[2] * silu_f(bflo(zr.w)); r[7] = o1[3] * rs * g1[3] * silu_f(bfhi(zr.w));
        u32x4 wv; wv.x = pk2(r[0], r[1]); wv.y = pk2(r[2], r[3]); wv.z = pk2(r[4], r[5]); wv.w = pk2(r[6], r[7]);
        *(u32x4*)(MIX + (size_t)row * DM + lane * 8) = wv;
    }
}

__global__ void __launch_bounds__(512) mk_fwd(Args a) {
    extern __shared__ __attribute__((aligned(16))) unsigned char lds_raw[];
    LAS unsigned char* lds = (LAS unsigned char*)lds_raw;
    cg::grid_group grid = cg::this_grid();
    const int G = gridDim.x;
    volatile LAS unsigned* xst = (volatile LAS unsigned*)(lds + LDS_MAIN);
    if (threadIdx.x < 4) xst[threadIdx.x] = 0u;
    __syncthreads();
    (void)xcd_barrier_post((unsigned*)(a.ws + WS_BAR), xst);
    for (int ph = a.ph_lo; ph < a.ph_hi; ++ph) {
        if (ph > a.ph_lo) { if (ph == 1) grid.sync(); else { XcdBarrier xbar; xbar.bar = (unsigned*)(a.ws + WS_BAR); xbar.x = xb_xcc_id(); xbar.st = (volatile LAS unsigned*)(lds + LDS_MAIN); xcd_barrier(xbar); } }
        if (ph == 0) { if (PHON(0)) prep_phase(lds, a); continue; }
        const int l = (ph - 1) / 12, k = (ph - 1) % 12;
        const unsigned char* Wl = a.ws + WS_W + (size_t)l * W_LSTRIDE;
        if (PHON(1) && (k == 0 || k == 9)) {
            pg8::Gemm g{(const bf16_t*)(a.ws + WS_XB), (const bf16_t*)(Wl + (k == 0 ? WO_GU1 : WO_GU2)), ROWS, 5632, DM};
            pg8::StaticOrder S; S.init(ROWS, 5632, DM, G, (int)blockIdx.x, 0);
            EpiSwiglu E{(bf16_t*)(a.ws + WS_HID)};
            pg8::gemm_phase<EpiSwiglu, pg8::StaticOrder>(lds, g, S, E);
        } else if (PHON(2) && (k == 1 || k == 10 || k == 7)) {
            pg8::Gemm g{(const bf16_t*)(a.ws + (k == 7 ? WS_MIX : WS_HID)), (const bf16_t*)(Wl + (k == 1 ? WO_D1 : (k == 10 ? WO_D2 : WO_WOUT))), ROWS, DM, k == 7 ? DM : FF};
            pg8::StaticOrder S; S.init(NPROMPT, DM, k == 7 ? DM : FF, G, (int)blockIdx.x, k == 7 ? 4 : 11);
            EpiResid E{(float*)(a.ws + WS_R), (float*)(a.ws + WS_PART), k == 7 ? 1.0f : 0.5f};
            pg8::gemm_phase<EpiResid, pg8::StaticOrder>(lds, g, S, E);
        } else if (PHON(3) && (k == 2 || k == 8 || k == 11)) {
            ln_phase(lds, a, l, k == 2 ? 1 : (k == 8 ? 2 : 3));
        } else if (PHON(4) && k == 3) {
            pg8::Gemm g{(const bf16_t*)(a.ws + WS_XB), (const bf16_t*)(Wl + WO_WIN), ROWS, NPROJ, DM};
            pg8::StaticOrder S; S.init(ROWS, NPROJ, DM, G, (int)blockIdx.x, 0);
            EpiProj E{(bf16_t*)(a.ws + WS_HID), a.out, l};
            pg8::gemm_phase<EpiProj, pg8::StaticOrder>(lds, g, S, E);
        } else if (k == 4) {
            for (int it = blockIdx.x; it < 512; it += G) {
                if (PHON(5)) { int tq = threadIdx.x; asm volatile("" : "+v"(tq)); const int hb = tq >> 8; dprep_item(lds + hb * 69632, a, l, it * 2 + hb, tq & 255); }
            }
        } else if (PHON(8) && k == 5) {
            if ((int)blockIdx.x < 32 || G <= 32) scan_phase(lds, a, l);
            if (G <= 32) __syncthreads();
            if ((int)blockIdx.x >= 32 || G <= 32) {
                const int nb = (G > 32) ? G - 32 : G, b0 = (G > 32) ? (int)blockIdx.x - 32 : (int)blockIdx.x;
                for (int it = b0; it < 512 + 516; it += nb) {
                    if (PHON(6) && it < 512) sample_item(lds, a, l, it);
                    else if (PHON(7) && it >= 512) pool_item(lds, a, l, it - 512);
                }
            }
        } else if (PHON(9) && k == 6) {
            gate_phase(a, l);
        }
    }
}

extern "C" void kernel_launch(void* const* d_in, const int* in_sizes, int n_in, void* d_out, int out_size, void* d_ws, size_t ws_size, hipStream_t stream) {
    static int grid = 0;
    if (grid == 0) {
        if (n_in != 25 || ws_size < WS_END) { fprintf(stderr, "kernel_launch: need 25 inputs and >= %zu bytes of workspace; got %d, %zu\n", (size_t)WS_END, n_in, ws_size); grid = -1; return; }
        int dev = 0, cus = 0, per_cu = 0;
        hipGetDevice(&dev); hipDeviceGetAttribute(&cus, hipDeviceAttributeMultiprocessorCount, dev);
        if (hipFuncSetAttribute((const void*)mk_fwd, hipFuncAttributeMaxDynamicSharedMemorySize, LDS_BYTES) != hipSuccess) { fprintf(stderr, "kernel_launch: hipFuncSetAttribute failed\n"); grid = -1; return; }
        if (hipOccupancyMaxActiveBlocksPerMultiprocessor(&per_cu, (const void*)mk_fwd, 512, LDS_BYTES) != hipSuccess || per_cu < 1) { fprintf(stderr, "kernel_launch: occupancy query gave %d\n", per_cu); per_cu = 1; }
        (void)hipGetLastError();
        grid = cus * 1;
        if (grid <= 0) grid = 256;
    }
    if (grid < 0) return;
    Args a{};
    for (int i = 0; i < 25; ++i) a.in[i] = (const float*)d_in[i];
    a.out = (float*)d_out; a.ws = (unsigned char*)d_ws;
#if MK_MULTI
    for (int ph = 0; ph < NPH; ++ph) { a.ph_lo = ph; a.ph_hi = ph + 1; hipLaunchKernelGGL(mk_fwd, dim3(grid), dim3(512), LDS_BYTES, stream, a); }
#else
    a.ph_lo = 0; a.ph_hi = NPH;
    if (hipMemsetAsync((char*)d_ws + WS_BAR, 0, 16384, stream) != hipSuccess) { fprintf(stderr, "kernel_launch: memset of barrier words failed\n"); return; }
    void* args[] = {&a};
    hipError_t e = hipLaunchCooperativeKernel((const void*)mk_fwd, dim3(grid), dim3(512), args, LDS_BYTES, stream);
    if (e != hipSuccess) fprintf(stderr, "cooperative launch failed: %s (grid %d)\n", hipGetErrorString(e), grid);
#endif
}
```

```cpp
#include <hip/hip_runtime.h>
#include <hip/hip_cooperative_groups.h>
#include <cstdio>
namespace cg = cooperative_groups;

#ifndef MK_MULTI
#define MK_MULTI 0
#endif

#ifndef PHMASK
#define PHMASK 0xFFFF
#endif
#define PHON(i) ((PHMASK >> (i)) & 1)
#define LAS __attribute__((address_space(3)))
typedef unsigned short bf16_t;
typedef short bf16x8 __attribute__((ext_vector_type(8)));
typedef float f32x4 __attribute__((ext_vector_type(4)));
typedef float f32x2 __attribute__((ext_vector_type(2)));
typedef unsigned u32x4 __attribute__((ext_vector_type(4)));
typedef unsigned u32x2 __attribute__((ext_vector_type(2)));
typedef __bf16 nbf2 __attribute__((ext_vector_type(2)));
#define DI __device__ __forceinline__

constexpr int DM = 1024, FF = 2816, NPROMPT = 16384, NSAMP = 128, NVALID = 16512, ROWS = 16640, DEPTH = 4;
constexpr int NPROJ = 2560, INDIM = 2568, QKVD = 1536;
constexpr float ALPHA = 1.681792830507429f;
constexpr int LDS_MAIN = 139264, LDS_BYTES = LDS_MAIN + 16;
constexpr int NPH = 1 + 12 * DEPTH;

constexpr size_t SZ_GU = (size_t)5632 * 1024 * 2, SZ_D = (size_t)1024 * 2816 * 2, SZ_WIN = (size_t)2560 * 1024 * 2, SZ_WOUT = (size_t)1024 * 1024 * 2, SZ_PW = (size_t)4 * 128 * 128 * 2;
constexpr size_t WO_GU1 = 0, WO_D1 = WO_GU1 + SZ_GU, WO_WIN = WO_D1 + SZ_D, WO_WOUT = WO_WIN + SZ_WIN, WO_GU2 = WO_WOUT + SZ_WOUT, WO_D2 = WO_GU2 + SZ_GU, WO_PW = WO_D2 + SZ_D, W_LSTRIDE = WO_PW + SZ_PW;
constexpr size_t WS_W = 0;
constexpr size_t WS_R = WS_W + DEPTH * W_LSTRIDE;
constexpr size_t WS_XB = WS_R + (size_t)ROWS * DM * 4;
constexpr size_t WS_HID = WS_XB + (size_t)ROWS * DM * 2;
constexpr size_t WS_MIX = WS_HID + (size_t)ROWS * FF * 2;
constexpr size_t WS_O = WS_MIX + (size_t)ROWS * DM * 2;
constexpr size_t WS_BETA = WS_O + (size_t)ROWS * 512 * 4;
constexpr size_t WS_G = WS_BETA + (size_t)ROWS * 16;
constexpr size_t WS_UV = WS_G + (size_t)ROWS * 16;
constexpr size_t WS_WK = WS_UV + (size_t)1024 * 8192 * 4;
constexpr size_t WS_QD = WS_WK + (size_t)1024 * 8192 * 2;
constexpr size_t WS_KET = WS_QD + (size_t)1024 * 8192 * 2;
constexpr size_t WS_QK = WS_KET + (size_t)1024 * 8192 * 2;
constexpr size_t WS_GE = WS_QK + (size_t)1024 * 4096 * 2;
constexpr size_t WS_BAR = WS_GE + 4096;
constexpr size_t WS_PART = WS_BAR + 16384;
constexpr size_t WS_END = WS_PART + (size_t)11 * 256 * 1024 * 4;

constexpr size_t OUT_YP = 0, OUT_YS = 16777216, OUT_DP = 16908288, OUT_CP = 19005440, OUT_PP = 19152896, OUT_DS = 19398656, OUT_CS = 52953088, OUT_PS = 55312384;

struct Args { const float* in[25]; float* out; unsigned char* ws; int ph_lo, ph_hi; };

DI const float* INP(const Args& a, int i) { asm volatile("" : "+s"(i)); return a.in[i]; }
DI unsigned pk2(float a, float b) { f32x2 v = {a, b}; nbf2 r = __builtin_convertvector(v, nbf2); return __builtin_bit_cast(unsigned, r); }
DI bf16_t f2bf(float a) { return (bf16_t)(pk2(a, 0.f) & 0xffffu); }
DI float bflo(unsigned w) { return __uint_as_float(w << 16); }
DI float bfhi(unsigned w) { return __uint_as_float(w & 0xffff0000u); }
DI float bf2f(bf16_t b) { return __uint_as_float(((unsigned)b) << 16); }
DI float silu_f(float x) { return x * __builtin_amdgcn_rcpf(1.f + __expf(-x)); }
DI float wave_sum(float v) {
#pragma unroll
    for (int o = 32; o > 0; o >>= 1) v += __shfl_xor(v, o);
    return v;
}
DI bf16x8 pack8(const f32x4& a, const f32x4& b) { u32x4 p; p.x = pk2(a[0], a[1]); p.y = pk2(a[2], a[3]); p.z = pk2(b[0], b[1]); p.w = pk2(b[2], b[3]); return __builtin_bit_cast(bf16x8, p); }
DI int perm6(int j) { return (j & 32) | (((j >> 2) & 3) << 3) | (((j >> 4) & 1) << 2) | (j & 3); }
DI int perm7(int j) { return (j & 96) | (((j >> 2) & 3) << 3) | (((j >> 4) & 1) << 2) | (j & 3); }
#define MFMA16(a, b, c) __builtin_amdgcn_mfma_f32_16x16x32_bf16((a), (b), (c), 0, 0, 0)


#define XB_TMO      128
#define XB_XCNT(j)  (256  + 64 * (j))
#define XB_XSUB(j)  (1280 + 64 * (j))
#define XB_XGEN(j)  (2304 + 64 * (j))
#define XB_TOP      3328
#define XB_TOPGEN   3392
#define XCD_BAR_WORDS 3456
#define XB_SPIN_CAP (1u << 22)
DI unsigned xb_ld(unsigned* p)              { return __hip_atomic_load(p, __ATOMIC_RELAXED, __HIP_MEMORY_SCOPE_AGENT); }
DI unsigned xb_add(unsigned* p, unsigned v) { return __hip_atomic_fetch_add(p, v, __ATOMIC_RELAXED, __HIP_MEMORY_SCOPE_AGENT); }
DI unsigned xb_xcc_id() { return (unsigned)__builtin_amdgcn_s_getreg((3 << 11) | 20) & 0xFu; }
#define XB_SPIN(cond, bar) do { unsigned _sp = 0; while (cond) { __builtin_amdgcn_s_sleep(1); \
    if ((++_sp & 255u) == 0u) { if (xb_ld(&(bar)[XB_TMO])) break; if (_sp > XB_SPIN_CAP) { atomicAdd(&(bar)[XB_TMO], 1u); break; } } } } while (0)
struct XcdBarrier { unsigned* bar; unsigned x; volatile LAS unsigned* st; };
DI XcdBarrier xcd_barrier_post(unsigned* bar, volatile LAS unsigned* st) {
    XcdBarrier b; b.bar = bar; b.x = xb_xcc_id(); b.st = st;
    if (threadIdx.x == 0) (void)xb_add(&bar[XB_XCNT(b.x)], 1u);
    return b;
}
DI void xcd_barrier_complete(unsigned* bar, unsigned x, unsigned& nloc, unsigned& nx) {
    const unsigned G = gridDim.x * gridDim.y * gridDim.z;
    unsigned sum, cnt, mine, sp = 0u;
    for (;;) {
        sum = 0u; cnt = 0u; mine = 0u;
#pragma unroll
        for (unsigned j = 0; j < 16; ++j) { const unsigned c = xb_ld(&bar[XB_XCNT(j)]); sum += c; cnt += (c > 0u) ? 1u : 0u; mine = (j == x) ? c : mine; }
        if (sum == G) break;
        __builtin_amdgcn_s_sleep(1);
        if ((++sp & 255u) == 0u) { if (xb_ld(&bar[XB_TMO])) break; if (sp > XB_SPIN_CAP) { atomicAdd(&bar[XB_TMO], 1u); break; } }
    }
    nloc = mine > 0u ? mine : 1u; nx = cnt > 0u ? cnt : 1u;
}
DI void xcd_barrier(const XcdBarrier& b) {
    asm volatile("s_waitcnt vmcnt(0)" ::: "memory");
    __syncthreads();
    if (threadIdx.x == 0) {
        unsigned* bar = b.bar;
        __builtin_amdgcn_s_waitcnt(0);
        unsigned nloc = b.st[0], nx = b.st[1];
        if (nloc == 0u) { xcd_barrier_complete(bar, b.x, nloc, nx); b.st[0] = nloc; b.st[1] = nx; }
        const unsigned old = xb_add(&bar[XB_XSUB(b.x)], 1u);
        const unsigned gen = old / nloc;
        if (old + 1u == (gen + 1u) * nloc) {
            __builtin_amdgcn_fence(__ATOMIC_RELEASE, "agent");
            asm volatile("s_waitcnt vmcnt(0)" ::: "memory");
            const unsigned og = xb_add(&bar[XB_TOP], 1u);
            const unsigned tg = og / nx;
            if (og + 1u == (tg + 1u) * nx) xb_add(&bar[XB_TOPGEN], 1u);
            else XB_SPIN(xb_ld(&bar[XB_TOPGEN]) == tg, bar);
            __builtin_amdgcn_fence(__ATOMIC_ACQUIRE, "agent");
            xb_add(&bar[XB_XGEN(b.x)], 1u);
            asm volatile("s_waitcnt vmcnt(0)" ::: "memory");
        } else {
            XB_SPIN(xb_ld(&bar[XB_XGEN(b.x)]) == gen, bar);
            __builtin_amdgcn_fence(__ATOMIC_ACQUIRE, "agent");
            asm volatile("s_waitcnt vmcnt(0)" ::: "memory");
        }
    }
    __syncthreads();
}

namespace pg8 {
constexpr int BM = 256, BK = 64, HALF = 128, HTB = HALF * BK * 2, STAGE_BYTES = 8 * HTB, NXCD = 8, WGM = 8;
DI int lds_byte(int r, int c) { const int st = (r >> 4) * 2 + (c >> 5), rr = r & 15, cc = c & 31, ob = rr * 64 + cc * 2; return st * 1024 + (ob ^ (((ob >> 9) & 1) << 5)); }
DI void stage_rc(int b, int& R, int& C) { const int st = b / 1024, sb = b % 1024, swz = sb ^ (((sb >> 9) & 1) << 5); R = (st >> 1) * 16 + swz / 64; C = (st & 1) * 32 + (swz % 64) / 2; }
struct Unit { int pm, pn, kt0, nt, split; };
struct Gemm { const bf16_t* A; const bf16_t* Bt; int M, N, K; };
struct StaticOrder {
    int nM, nN, nwg, G, c, ntFull, ntSplit, ntot;
    DI void init(int M, int N, int K, int G_, int c_, int parts) { nM = M / BM; nN = N / BM; nwg = nM * nN; G = G_; c = c_; ntFull = K / BK; ntSplit = parts > 0 ? ntFull / parts : ntFull; ntot = nwg + 4 * parts; }
    DI bool next(int i, Unit& u) const {
        const int L = i * G + c;
        if (L >= ntot) return false;
        const bool sp = L >= nwg;
        int wgid = sp ? 0 : L; { const int q = nwg / NXCD, r = nwg % NXCD, xcd = wgid % NXCD, off = wgid / NXCD; wgid = (xcd < r ? xcd * (q + 1) : r * (q + 1) + (xcd - r) * q) + off; }
        const int nig = WGM * nN, gid = wgid / nig, fm = gid * WGM, gsz = (nM - fm) < WGM ? (nM - fm) : WGM;
        const int pm_s = fm + ((wgid % nig) % gsz), pn_s = (wgid % nig) / gsz;
        const int j = sp ? L - nwg : 0;
        u.pm = sp ? nM : pm_s; u.pn = sp ? (j & 3) : pn_s; u.kt0 = sp ? (j >> 2) * ntSplit : 0; u.nt = sp ? ntSplit : ntFull; u.split = sp ? 1 : 0;
        return true;
    }
};

template <class Epi, class Sched>
DI void gemm_phase(LAS unsigned char* lds, const Gemm g, const Sched& S, const Epi& E) {
    int tid_ = threadIdx.x; asm volatile("" : "+v"(tid_));
    const int tid = tid_, wid = __builtin_amdgcn_readfirstlane(tid >> 6), lane = tid & 63, wr = wid >> 2, wc = wid & 3, fr = lane & 15, fq = lane >> 4;
    const int K = g.K;
    unsigned voffA[2], voffB[2];
#pragma unroll
    for (int i = 0; i < 2; ++i) { int R, C; stage_rc(tid * 16 + i * 8192, R, C); voffA[i] = (unsigned)(R * K + C) * 2u; voffB[i] = voffA[i]; }
    const size_t kstep = (size_t)(BK * 2);
    const size_t hstep = (size_t)HALF * K * 2;
    const size_t tstep = 2 * hstep;
    const unsigned ldsw = (unsigned)wid * 1024u;
    const int aoff = lds_byte(wr * 64 + fr, fq * 8), boff = lds_byte(wc * 32 + fr, fq * 8);
#define PG8_SA(b, h) (((b) * 2 + (h)) * HTB)
#define PG8_SB(b, h) ((4 + (b) * 2 + (h)) * HTB)
#define PG8_STAGE(bufoff, gbase, voff) do { _Pragma("unroll") for (int _i = 0; _i < 2; ++_i) \
        __builtin_amdgcn_global_load_lds((const unsigned*)((const char*)(gbase) + (voff)[_i]), (LAS unsigned*)(lds + (bufoff) + ldsw + _i * 8192), 16, 0, 0); } while (0)
#define PG8_LDA(dst, b, h) do { _Pragma("unroll") for (int m = 0; m < 4; ++m) _Pragma("unroll") for (int k = 0; k < 2; ++k) dst[m][k] = *(const LAS bf16x8*)(lds + PG8_SA(b, h) + aoff + m * 2048 + k * 1024); } while (0)
#define PG8_LDB(dst, b, h) do { _Pragma("unroll") for (int n = 0; n < 2; ++n) _Pragma("unroll") for (int k = 0; k < 2; ++k) dst[n][k] = *(const LAS bf16x8*)(lds + PG8_SB(b, h) + boff + n * 2048 + k * 1024); } while (0)
#define PG8_MMA(ai, bj, At, Bt) do { __builtin_amdgcn_s_setprio(1); _Pragma("unroll") for (int m = 0; m < 4; ++m) _Pragma("unroll") for (int n = 0; n < 2; ++n) _Pragma("unroll") for (int k = 0; k < 2; ++k) \
        acc[ai][bj][m][n] = __builtin_amdgcn_mfma_f32_16x16x32_bf16(Bt[n][k], At[m][k], acc[ai][bj][m][n], 0, 0, 0); __builtin_amdgcn_s_setprio(0); } while (0)
#define PG8_WAIT_V(n) asm volatile("s_waitcnt vmcnt(" #n ")" ::: "memory")
#define PG8_WAIT_L(n) asm volatile("s_waitcnt lgkmcnt(" #n ")" ::: "memory")
#define PG8_BAR __builtin_amdgcn_s_barrier()
#define PG8_SCHED __builtin_amdgcn_sched_barrier(0)
    Unit cur, nxt; int ui = 0;
    if (!S.next(0, cur)) return;
    f32x4 acc[2][2][4][2];
#pragma unroll
    for (int a = 0; a < 2; ++a)
#pragma unroll
        for (int b = 0; b < 2; ++b)
#pragma unroll
            for (int m = 0; m < 4; ++m)
#pragma unroll
                for (int n = 0; n < 2; ++n) acc[a][b][m][n] = (f32x4){0.f, 0.f, 0.f, 0.f};
    bf16x8 At[4][2], B0[2][2], B1[2][2];
    const char* cA = (const char*)g.A + (size_t)cur.pm * tstep + (size_t)cur.kt0 * kstep; const char* cB = (const char*)g.Bt + (size_t)cur.pn * tstep + (size_t)cur.kt0 * kstep;
    PG8_STAGE(PG8_SB(0, 0), cB, voffB); PG8_STAGE(PG8_SA(0, 0), cA, voffA); PG8_STAGE(PG8_SB(0, 1), cB + hstep, voffB); PG8_STAGE(PG8_SA(0, 1), cA + hstep, voffA);
    if (wr == 1) PG8_BAR;
    PG8_WAIT_V(4); PG8_BAR;
    PG8_STAGE(PG8_SB(1, 0), cB + kstep, voffB); PG8_STAGE(PG8_SA(1, 0), cA + kstep, voffA); PG8_STAGE(PG8_SB(1, 1), cB + hstep + kstep, voffB);
    PG8_WAIT_V(6); PG8_BAR;
    for (;;) {
        const bool has_next = S.next(ui + 1, nxt);
        const char* nA = has_next ? (const char*)g.A + (size_t)nxt.pm * tstep + (size_t)nxt.kt0 * kstep : cA; const char* nB = has_next ? (const char*)g.Bt + (size_t)nxt.pn * tstep + (size_t)nxt.kt0 * kstep : cB;
        const int nt = cur.nt;
        for (int t = 0; t < nt; t += 2) {
            const bool last = (t == nt - 2);
            const char* a1 = cA + (size_t)(t + 1) * kstep;
            const char* a2 = last ? nA : cA + (size_t)(t + 2) * kstep; const char* b2 = last ? nB : cB + (size_t)(t + 2) * kstep;
            const char* a3 = a2 + kstep; const char* b3 = b2 + kstep;
            PG8_LDB(B0, 0, 0); PG8_SCHED; PG8_LDA(At, 0, 0); PG8_STAGE(PG8_SA(1, 1), a1 + hstep, voffA);
            PG8_WAIT_L(8); PG8_BAR; PG8_WAIT_L(0); PG8_MMA(0, 0, At, B0); PG8_BAR; PG8_SCHED;
            PG8_LDB(B1, 0, 1); PG8_STAGE(PG8_SB(0, 0), b2, voffB);
            PG8_BAR; PG8_WAIT_L(0); PG8_MMA(0, 1, At, B1); PG8_BAR;
            PG8_LDA(At, 0, 1); PG8_STAGE(PG8_SA(0, 0), a2, voffA);
            PG8_BAR; PG8_WAIT_L(0); PG8_MMA(1, 0, At, B0); PG8_BAR; PG8_SCHED;
            PG8_STAGE(PG8_SB(0, 1), b2 + hstep, voffB);
            PG8_WAIT_V(6); PG8_BAR; PG8_MMA(1, 1, At, B1); PG8_BAR;
            PG8_LDB(B0, 1, 0); PG8_SCHED; PG8_LDA(At, 1, 0); PG8_STAGE(PG8_SA(0, 1), a2 + hstep, voffA);
            PG8_WAIT_L(8); PG8_BAR; PG8_WAIT_L(0); PG8_MMA(0, 0, At, B0); PG8_BAR; PG8_SCHED;
            PG8_LDB(B1, 1, 1); PG8_STAGE(PG8_SB(1, 0), b3, voffB);
            PG8_BAR; PG8_WAIT_L(0); PG8_MMA(0, 1, At, B1); PG8_BAR;
            PG8_LDA(At, 1, 1); PG8_STAGE(PG8_SA(1, 0), a3, voffA);
            PG8_BAR; PG8_WAIT_L(0); PG8_MMA(1, 0, At, B0); PG8_BAR; PG8_SCHED;
            PG8_STAGE(PG8_SB(1, 1), b3 + hstep, voffB);
            PG8_WAIT_V(6); PG8_BAR; PG8_MMA(1, 1, At, B1); PG8_BAR;
        }
        E(acc, cur, wr, wc, fr, fq);
        if (!has_next) break;
#pragma unroll
        for (int a = 0; a < 2; ++a)
#pragma unroll
            for (int b = 0; b < 2; ++b)
#pragma unroll
                for (int m = 0; m < 4; ++m)
#pragma unroll
                    for (int n = 0; n < 2; ++n) acc[a][b][m][n] = (f32x4){0.f, 0.f, 0.f, 0.f};
        cur = nxt; cA = nA; cB = nB; ++ui;
    }
    PG8_WAIT_V(0);
    if (wr == 0) PG8_BAR;
    PG8_BAR;
#undef PG8_SA
#undef PG8_SB
#undef PG8_STAGE
#undef PG8_LDA
#undef PG8_LDB
#undef PG8_MMA
#undef PG8_WAIT_V
#undef PG8_WAIT_L
#undef PG8_BAR
#undef PG8_SCHED
}
}

struct EpiResid {
    float* R; float* PART; float scale;
    DI void operator()(const f32x4 (&acc)[2][2][4][2], const pg8::Unit& u, int wr, int wc, int fr, int fq) const {
        const int row0 = u.pm * 256 + wr * 64 + fr, col0 = u.pn * 256 + wc * 32 + 4 * fq;
        const bf16_t* XBr = (const bf16_t*)((const unsigned char*)R + (WS_XB - WS_R));
        if (u.split) {
            float* P0 = PART + ((size_t)(u.kt0 / u.nt) * 256 + (wr * 64 + fr)) * DM + col0;
#pragma unroll
            for (int ai = 0; ai < 2; ++ai)
#pragma unroll
                for (int m = 0; m < 4; ++m) { float* rowp = P0 + (size_t)(ai * 128 + m * 16) * DM;
#pragma unroll
                    for (int bj = 0; bj < 2; ++bj)
#pragma unroll
                        for (int n = 0; n < 2; ++n) *(f32x4*)(rowp + bj * 128 + n * 16) = acc[ai][bj][m][n] * scale; }
            return; }
#pragma unroll
        for (int ai = 0; ai < 2; ++ai)
#pragma unroll
            for (int m = 0; m < 4; ++m) { float* rowp = R + (size_t)(row0 + ai * 128 + m * 16) * DM + col0;
#pragma unroll
                for (int bj = 0; bj < 2; ++bj)
#pragma unroll
                    for (int n = 0; n < 2; ++n) { const u32x2 hb = *(const u32x2*)(XBr + (size_t)(row0 + ai * 128 + m * 16) * DM + col0 + bj * 128 + n * 16);
                        const f32x4 r = (f32x4){bflo(hb.x), bfhi(hb.x), bflo(hb.y), bfhi(hb.y)} * ALPHA; *(f32x4*)(rowp + bj * 128 + n * 16) = r + acc[ai][bj][m][n] * scale; }
                if (m & 1) asm volatile("" ::: "memory"); }
    }
};
struct EpiSwiglu {
    bf16_t* H;
    DI void operator()(const f32x4 (&acc)[2][2][4][2], const pg8::Unit& u, int wr, int wc, int fr, int fq) const {
        const int row0 = u.pm * 256 + wr * 64 + fr, col0 = u.pn * 128 + wc * 32 + 8 * fq;
#pragma unroll
        for (int ai = 0; ai < 2; ++ai)
#pragma unroll
            for (int m = 0; m < 4; ++m) { bf16_t* rowp = H + (size_t)(row0 + ai * 128 + m * 16) * FF + col0;
                float h[8];
#pragma unroll
                for (int bj = 0; bj < 2; ++bj)
#pragma unroll
                    for (int j = 0; j < 4; j += 2) { const f32x2 g2 = {acc[ai][bj][m][0][j], acc[ai][bj][m][0][j + 1]}, u2 = {acc[ai][bj][m][1][j], acc[ai][bj][m][1][j + 1]};
                        const f32x2 t2 = g2 * (-1.4426950408889634f); f32x2 e2; e2[0] = __builtin_amdgcn_exp2f(t2[0]); e2[1] = __builtin_amdgcn_exp2f(t2[1]);
                        const f32x2 d2 = e2 + 1.0f; f32x2 r2; r2[0] = __builtin_amdgcn_rcpf(d2[0]); r2[1] = __builtin_amdgcn_rcpf(d2[1]);
                        const f32x2 h2 = (g2 * u2) * r2; h[bj * 4 + j] = h2[0]; h[bj * 4 + j + 1] = h2[1]; }
                u32x4 w; w.x = pk2(h[0], h[1]); w.y = pk2(h[2], h[3]); w.z = pk2(h[4], h[5]); w.w = pk2(h[6], h[7]);
                *(u32x4*)rowp = w; asm volatile("" ::: "memory"); }
    }
};
struct EpiProj {
    bf16_t* P; float* out; int layer;
    DI void operator()(const f32x4 (&acc)[2][2][4][2], const pg8::Unit& u, int wr, int wc, int fr, int fq) const {
        const int row0 = u.pm * 256 + wr * 64 + fr, colL = wc * 32 + 8 * fq;
        const bool special = ((u.pm & 7) == 7 || u.pm == 64) && (u.pn < 6 || u.pn >= 8);
#pragma unroll
        for (int ai = 0; ai < 2; ++ai)
#pragma unroll
            for (int m = 0; m < 4; ++m) { const int r = row0 + ai * 128 + m * 16;
#pragma unroll
                for (int bj = 0; bj < 2; ++bj) { const int pc = u.pn * 256 + bj * 128 + colL; const f32x4 v0 = acc[ai][bj][m][0], v1 = acc[ai][bj][m][1];
                    u32x4 w; w.x = pk2(v0[0], v0[1]); w.y = pk2(v0[2], v0[3]); w.z = pk2(v1[0], v1[1]); w.w = pk2(v1[2], v1[3]);
                    *(u32x4*)(P + (size_t)r * NPROJ + pc) = w;
                    if (special) { float* dst = nullptr;
                        if (r < NPROMPT) { const int tpos = r & 2047, b = r >> 11;
                            if (pc < QKVD) { if (tpos >= 2045) dst = out + OUT_CP + ((size_t)(layer * 8 + b) * 3 + (tpos - 2045)) * QKVD + pc; }
                            else if (pc >= 2048) { if (tpos >= 2033) dst = out + OUT_PP + ((size_t)(layer * 8 + b) * 15 + (tpos - 2033)) * 512 + (pc - 2048); } }
                        else if (r < NVALID) { const int b = r - NPROMPT;
                            if (pc < QKVD) dst = out + OUT_CS + ((size_t)(layer * 128 + b) * 3 + 2) * QKVD + pc;
                            else if (pc >= 2048) dst = out + OUT_PS + ((size_t)(layer * 128 + b) * 15 + 14) * 512 + (pc - 2048); }
                        if (dst) { *(f32x4*)dst = v0; *(f32x4*)(dst + 4) = v1; } } }
                asm volatile("" ::: "memory"); }
    }
};

DI void prep_phase(LAS unsigned char* lds, const Args& a) {
    LAS bf16_t* tile = (LAS bf16_t*)lds;
    LAS unsigned* t32 = (LAS unsigned*)lds;
    int tid_ = threadIdx.x; asm volatile("" : "+v"(tid_));
    const int tid = tid_, c = tid & 255, kh = tid >> 8;
    const int it_lo = (int)(((long)blockIdx.x * (DEPTH * 1280)) / gridDim.x), it_hi = (int)(((long)(blockIdx.x + 1) * (DEPTH * 1280)) / gridDim.x);
    for (int it = it_lo; it < it_hi; ++it) {
        const int l = it / 1280; int r = it % 1280;
        const float* src0; const float* src1 = nullptr; int Nsrc, K, pn, kt, kind; size_t dsto;
        if (r < 352) { kind = 0; pn = r / 16; kt = r % 16; src0 = INP(a, 7) + (size_t)l * DM * FF; src1 = INP(a, 8) + (size_t)l * DM * FF; Nsrc = FF; K = DM; dsto = WO_GU1; }
        else if (r < 704) { r -= 352; kind = 0; pn = r / 16; kt = r % 16; src0 = INP(a, 20) + (size_t)l * DM * FF; src1 = INP(a, 21) + (size_t)l * DM * FF; Nsrc = FF; K = DM; dsto = WO_GU2; }
        else if (r < 880) { r -= 704; kind = 1; pn = r / 44; kt = r % 44; src0 = INP(a, 9) + (size_t)l * FF * DM; Nsrc = DM; K = FF; dsto = WO_D1; }
        else if (r < 1056) { r -= 880; kind = 1; pn = r / 44; kt = r % 44; src0 = INP(a, 22) + (size_t)l * FF * DM; Nsrc = DM; K = FF; dsto = WO_D2; }
        else if (r < 1216) { r -= 1056; kind = 2; pn = r / 16; kt = r % 16; src0 = INP(a, 10) + (size_t)l * DM * INDIM; Nsrc = INDIM; K = DM; dsto = WO_WIN; }
        else { r -= 1216; kind = 1; pn = r / 16; kt = r % 16; src0 = INP(a, 17) + (size_t)l * DM * DM; Nsrc = DM; K = DM; dsto = WO_WOUT; }
        const int w8 = tid >> 6, c4 = (tid & 63) * 4;
        const float* sp; int ldsrow;
        if (kind == 0) { const int which = c4 >> 7, hc = c4 & 127; sp = (which ? src1 : src0) + pn * 128 + hc; ldsrow = 128 * ((hc >> 2) & 1) + 32 * (hc >> 5) + 16 * which + 4 * ((hc >> 3) & 3) + (hc & 3); }
        else if (kind == 1) { sp = src0 + pn * 256 + c4; ldsrow = c4; }
        else { const int pc = pn * 256 + c4; sp = src0 + (pc < 2048 ? pc : pc + 8); ldsrow = 128 * (c4 >> 7) + 32 * ((c4 >> 5) & 3) + 16 * ((c4 >> 2) & 1) + 4 * ((c4 >> 3) & 3) + (c4 & 3); }
        const int k0 = kt * 64;
        sp += (size_t)(k0 + w8) * Nsrc;
        f32x4 tv[8];
#pragma unroll
        for (int it = 0; it < 8; ++it) tv[it] = __builtin_nontemporal_load((const f32x4*)(sp + (size_t)(8 * it) * Nsrc));
#pragma unroll
        for (int it = 0; it < 8; ++it)
#pragma unroll
            for (int j = 0; j < 4; ++j) tile[(ldsrow + j) * 66 + w8 + 8 * it] = f2bf(tv[it][j]);
        __syncthreads();
        unsigned* d32 = (unsigned*)(a.ws + WS_W + (size_t)l * W_LSTRIDE + dsto) + ((size_t)(pn * 256) * K + k0) / 2;
#pragma unroll
        for (int j = 0; j < 16; ++j) { const int idx = j * 512 + tid, row = idx >> 5, dw = idx & 31; d32[(size_t)row * (K / 2) + dw] = t32[row * 33 + dw]; }
        __syncthreads();
    }
    const size_t gt = (size_t)blockIdx.x * 512 + tid, gs = (size_t)gridDim.x * 512;
    for (size_t i = gt; i < (size_t)DEPTH * 4 * 128 * 128; i += gs) { const int d = (int)(i & 127), cc = (int)((i >> 7) & 127); const size_t lg = i >> 14; const int l = (int)(lg >> 2), g = (int)(lg & 3);
        ((bf16_t*)(a.ws + WS_W + (size_t)l * W_LSTRIDE + WO_PW))[(size_t)(g * 128 + d) * 128 + cc] = f2bf(INP(a, 15)[i]); }
    { float* R = (float*)(a.ws + WS_R); bf16_t* XB = (bf16_t*)(a.ws + WS_XB);
      for (size_t i = gt; i < (size_t)ROWS * 256; i += gs) { const size_t row = i >> 8; const int c4 = (int)(i & 255) * 4; f32x4 v = {0.f, 0.f, 0.f, 0.f};
          if (row < NPROMPT) v = *(const f32x4*)(INP(a, 0) + row * DM + c4); else if (row < NVALID) v = *(const f32x4*)(INP(a, 1) + (row - NPROMPT) * DM + c4);
          *(f32x4*)(R + row * DM + c4) = v * ALPHA; u32x2 w; w.x = pk2(v[0], v[1]); w.y = pk2(v[2], v[3]); *(u32x2*)(XB + row * DM + c4) = w; } }
    for (size_t i = gt; i < (size_t)DEPTH * 128 * 2 * QKVD; i += gs) { const size_t lb = i / (2 * QKVD), rem = i % (2 * QKVD); a.out[OUT_CS + lb * 3 * QKVD + rem] = INP(a, 3)[lb * 3 * QKVD + QKVD + rem]; }
    for (size_t i = gt; i < (size_t)DEPTH * 128 * 14 * 512; i += gs) { const size_t lb = i / (14 * 512), rem = i % (14 * 512); a.out[OUT_PS + lb * 15 * 512 + rem] = INP(a, 4)[lb * 15 * 512 + 512 + rem]; }
}

DI void ln_phase(LAS unsigned char* lds, const Args& a, int l, int mode) {
    int tid_ = threadIdx.x; asm volatile("" : "+v"(tid_));
    const int tid = tid_, wave = tid >> 6, lane = tid & 63;
    float* R = (float*)(a.ws + WS_R); bf16_t* XB = (bf16_t*)(a.ws + WS_XB);
    const float* gam = INP(a, mode == 1 ? 5 : (mode == 2 ? 18 : 23)) + l * DM;
    const float* bet = INP(a, mode == 1 ? 6 : (mode == 2 ? 19 : 24)) + l * DM;
    LAS float* w8s = (LAS float*)lds;
    if (mode == 1) { const float* win = INP(a, 10) + (size_t)l * DM * INDIM + 2048;
        for (int i = tid; i < 8192; i += 512) { const int k = i >> 3, c = i & 7; w8s[c * 1024 + k] = win[(size_t)k * INDIM + c]; }
        __syncthreads(); }
    f32x4 g4[4], b4[4];
#pragma unroll
    for (int i = 0; i < 4; ++i) { g4[i] = *(const f32x4*)(gam + 256 * i + 4 * lane); b4[i] = *(const f32x4*)(bet + 256 * i + 4 * lane); }
    float alog = 0.f, dtb = 0.f;
    if (mode == 1) { alog = INP(a, 12)[l * 4 + (lane & 3)]; dtb = INP(a, 13)[l * 4 + (lane & 3)]; }
    const bool wy = (mode == 3 && l == DEPTH - 1);
    f32x4 xn[4];
    { const int row = blockIdx.x * 8 + wave; if (row < ROWS) {
#pragma unroll
        for (int i = 0; i < 4; ++i) xn[i] = *(const f32x4*)(R + (size_t)row * DM + 256 * i + 4 * lane); } }
    for (int row = blockIdx.x * 8 + wave; row < ROWS; row += gridDim.x * 8) {
        float* rp = R + (size_t)row * DM;
        f32x4 x[4];
#pragma unroll
        for (int i = 0; i < 4; ++i) x[i] = xn[i];
        { const int nrow = row + gridDim.x * 8; if (nrow < ROWS) {
#pragma unroll
            for (int i = 0; i < 4; ++i) xn[i] = *(const f32x4*)(R + (size_t)nrow * DM + 256 * i + 4 * lane); } }
        if (row >= NPROMPT) { const int np = (mode == 2) ? 4 : 11; const float* pp = (const float*)(a.ws + WS_PART) + (size_t)(row - NPROMPT) * DM + 4 * lane;
#pragma unroll
            for (int i = 0; i < 4; ++i) { const u32x2 hb = *(const u32x2*)(XB + (size_t)row * DM + 256 * i + 4 * lane); x[i] = (f32x4){bflo(hb.x), bfhi(hb.x), bflo(hb.y), bfhi(hb.y)} * ALPHA; }
            for (int p = 0; p < np; ++p) {
#pragma unroll
                for (int i = 0; i < 4; ++i) x[i] += *(const f32x4*)(pp + (size_t)p * 256 * DM + 256 * i); } }
        float s = 0.f;
#pragma unroll
        for (int i = 0; i < 4; ++i) s += (x[i][0] + x[i][1]) + (x[i][2] + x[i][3]);
        const float mean = wave_sum(s) * (1.f / 1024.f);
        float q = 0.f;
#pragma unroll
        for (int i = 0; i < 4; ++i) { x[i] = x[i] - mean; q += (x[i][0] * x[i][0] + x[i][1] * x[i][1]) + (x[i][2] * x[i][2] + x[i][3] * x[i][3]); }
        const float rstd = rsqrtf(wave_sum(q) * (1.f / 1024.f) + 1e-5f);
#pragma unroll
        for (int i = 0; i < 4; ++i) { x[i] = x[i] * rstd * g4[i] + b4[i];
            u32x2 w; w.x = pk2(x[i][0], x[i][1]); w.y = pk2(x[i][2], x[i][3]); *(u32x2*)(XB + (size_t)row * DM + 256 * i + 4 * lane) = w; }
        if (wy) { if (row < NPROMPT) { float* yp = a.out + OUT_YP + (size_t)row * DM;
#pragma unroll
                for (int i = 0; i < 4; ++i) __builtin_nontemporal_store(x[i], (f32x4*)(yp + 256 * i + 4 * lane)); }
            else if (row < NVALID) { float* yp = a.out + OUT_YS + (size_t)(row - NPROMPT) * DM;
#pragma unroll
                for (int i = 0; i < 4; ++i) __builtin_nontemporal_store(x[i], (f32x4*)(yp + 256 * i + 4 * lane)); } }
        if (mode == 1) {
            float d0 = 0.f, d1 = 0.f, d2 = 0.f, d3 = 0.f, d4 = 0.f, d5 = 0.f, d6 = 0.f, d7 = 0.f;
#pragma unroll
            for (int i = 0; i < 4; ++i) { const int ko = 256 * i + 4 * lane; f32x4 w;
                w = *(const LAS f32x4*)(w8s + 0 * 1024 + ko); d0 += (x[i][0] * w[0] + x[i][1] * w[1]) + (x[i][2] * w[2] + x[i][3] * w[3]);
                w = *(const LAS f32x4*)(w8s + 1 * 1024 + ko); d1 += (x[i][0] * w[0] + x[i][1] * w[1]) + (x[i][2] * w[2] + x[i][3] * w[3]);
                w = *(const LAS f32x4*)(w8s + 2 * 1024 + ko); d2 += (x[i][0] * w[0] + x[i][1] * w[1]) + (x[i][2] * w[2] + x[i][3] * w[3]);
                w = *(const LAS f32x4*)(w8s + 3 * 1024 + ko); d3 += (x[i][0] * w[0] + x[i][1] * w[1]) + (x[i][2] * w[2] + x[i][3] * w[3]);
                w = *(const LAS f32x4*)(w8s + 4 * 1024 + ko); d4 += (x[i][0] * w[0] + x[i][1] * w[1]) + (x[i][2] * w[2] + x[i][3] * w[3]);
                w = *(const LAS f32x4*)(w8s + 5 * 1024 + ko); d5 += (x[i][0] * w[0] + x[i][1] * w[1]) + (x[i][2] * w[2] + x[i][3] * w[3]);
                w = *(const LAS f32x4*)(w8s + 6 * 1024 + ko); d6 += (x[i][0] * w[0] + x[i][1] * w[1]) + (x[i][2] * w[2] + x[i][3] * w[3]);
                w = *(const LAS f32x4*)(w8s + 7 * 1024 + ko); d7 += (x[i][0] * w[0] + x[i][1] * w[1]) + (x[i][2] * w[2] + x[i][3] * w[3]); }
            d0 = wave_sum(d0); d1 = wave_sum(d1); d2 = wave_sum(d2); d3 = wave_sum(d3); d4 = wave_sum(d4); d5 = wave_sum(d5); d6 = wave_sum(d6); d7 = wave_sum(d7);
            if (lane < 4) { const float braw = lane == 0 ? d0 : (lane == 1 ? d1 : (lane == 2 ? d2 : d3)); const float araw = lane == 0 ? d4 : (lane == 1 ? d5 : (lane == 2 ? d6 : d7));
                const float xx = araw + dtb; const float sp = xx > 20.f ? xx : log1pf(expf(xx));
                ((float*)(a.ws + WS_BETA))[(size_t)row * 4 + lane] = 1.f / (1.f + expf(-braw));
                ((float*)(a.ws + WS_G))[(size_t)row * 4 + lane] = -expf(alog) * sp; }
        }
    }
}

struct SolveCtx { const LAS float* Mm; const LAS float* betas; const LAS float* egs; const LAS bf16_t* colp; float* UVs; bf16_t* WKs; bool isv; };
template <int I>
DI void solve_row(const SolveCtx& c, f32x2 (&xp)[32], f32x4 (&lc)[8], f32x4 (&ln)[8], float bcur, float ecur, bf16_t ccur) {
    float bnx = 0.f, enx = 0.f; bf16_t cnx = 0;
    if constexpr (I + 1 < 64) {
#pragma unroll
        for (int q = 0; q < 8; ++q) if (4 * q < I + 1) ln[q] = *(const LAS f32x4*)(c.Mm + (I + 1) * 64 + 4 * q);
        bnx = c.betas[I + 1]; enx = c.egs[I + 1]; cnx = c.colp[(I + 1) * 136]; }
    __builtin_amdgcn_sched_barrier(0);
    float sc = bcur; if (!c.isv) sc *= ecur;
    f32x2 a01 = {sc * bf2f(ccur), 0.f}, a23 = {0.f, 0.f};
#pragma unroll
    for (int q = 0; q < 16; ++q) if (4 * q < I) { f32x4 mv; if (q < 8) mv = lc[q < 8 ? q : 0]; else mv = *(const LAS f32x4*)(c.Mm + I * 64 + 4 * q);
        if (4 * q + 1 < I) a01 -= (f32x2){mv[0], mv[1]} * xp[2 * q]; else a01[0] -= mv[0] * xp[2 * q][0];
        if (4 * q + 3 < I) a23 -= (f32x2){mv[2], mv[3]} * xp[2 * q + 1]; else if (4 * q + 2 < I) a23[0] -= mv[2] * xp[2 * q + 1][0]; }
    const float xi = (a01[0] + a01[1]) + (a23[0] + a23[1]);
    xp[I >> 1][I & 1] = xi;
    if (c.isv) { if constexpr ((I & 3) == 3) *(f32x4*)(c.UVs + (size_t)((I >> 4) * 64 + ((I >> 2) & 3) * 16) * 4) = (f32x4){xp[(I >> 1) - 1][0], xp[(I >> 1) - 1][1], xp[I >> 1][0], xi}; }
    else c.WKs[I * 128] = f2bf(xi);
    __builtin_amdgcn_sched_barrier(0);
    if constexpr (I + 1 < 64) solve_row<I + 1>(c, xp, ln, lc, bnx, enx, cnx);
}

DI void dprep_item(LAS unsigned char* ldsh, const Args& a, int l, int item, int tl) {
    const int n = item & 31, h = (item >> 5) & 3, b = item >> 7;
    const int r0 = b * 2048 + n * 64;
    LAS bf16_t* qn = (LAS bf16_t*)ldsh; LAS bf16_t* kn = qn + 64 * 136; LAS bf16_t* vv = kn + 64 * 136;
    LAS float* Mm = (LAS float*)(ldsh + 3 * 17408);
    LAS float* gcs = (LAS float*)(ldsh + 3 * 17408 + 16384); LAS float* betas = gcs + 64; LAS float* egs = gcs + 128;
    const bf16_t* PROJ = (const bf16_t*)(a.ws + WS_HID);
    const float* BETA = (const float*)(a.ws + WS_BETA); const float* G = (const float*)(a.ws + WS_G);
    { const int cg4 = tl & 31, rg = tl >> 5, c0 = cg4 * 4;
      for (int sec = 0; sec < 3; ++sec) {
          const int col = sec * 512 + h * 128 + c0;
          f32x4 w[4];
#pragma unroll
          for (int i = 0; i < 4; ++i) w[i] = *(const f32x4*)(INP(a, 11) + (size_t)(l * 4 + i) * QKVD + col);
          f32x4 xin[11];
#pragma unroll
          for (int i = 0; i < 11; ++i) { const int tpos = n * 64 + rg * 8 - 3 + i;
              if (tpos >= 0) { const u32x2 raw = *(const u32x2*)(PROJ + (size_t)(r0 + rg * 8 - 3 + i) * NPROJ + col); xin[i] = (f32x4){bflo(raw.x), bfhi(raw.x), bflo(raw.y), bfhi(raw.y)}; }
              else xin[i] = (f32x4){0.f, 0.f, 0.f, 0.f}; }
          LAS bf16_t* dst = sec == 0 ? qn : (sec == 1 ? kn : vv);
#pragma unroll
          for (int j = 0; j < 8; ++j) { f32x4 o = w[0] * xin[j] + w[1] * xin[j + 1] + w[2] * xin[j + 2] + w[3] * xin[j + 3];
              o[0] = silu_f(o[0]); o[1] = silu_f(o[1]); o[2] = silu_f(o[2]); o[3] = silu_f(o[3]);
              if (sec < 2) { float ss = (o[0] * o[0] + o[1] * o[1]) + (o[2] * o[2] + o[3] * o[3]);
                  ss += __shfl_xor(ss, 16); ss += __shfl_xor(ss, 8); ss += __shfl_xor(ss, 4); ss += __shfl_xor(ss, 2); ss += __shfl_xor(ss, 1);
                  const float sc = rsqrtf(ss + 1e-6f) * (sec == 0 ? 0.08838834764831845f : 1.f); o = o * sc; }
              u32x2 pw; pw.x = pk2(o[0], o[1]); pw.y = pk2(o[2], o[3]); *(LAS u32x2*)(dst + (rg * 8 + j) * 136 + c0) = pw; }
      } }
    if (tl < 64) { float g = G[(size_t)(r0 + tl) * 4 + h];
#pragma unroll
        for (int o = 1; o < 64; o <<= 1) { const float t = __shfl_up(g, o); if (tl >= o) g += t; }
        gcs[tl] = g; betas[tl] = BETA[(size_t)(r0 + tl) * 4 + h]; const float eg = expf(g); egs[tl] = eg;
        egs[64 + tl] = __expf(__shfl(g, 63) - g);
        if (tl == 63) ((float*)(a.ws + WS_GE))[item] = eg; }
    __syncthreads();
    { const int wl = tl >> 6, lane = tl & 63, fr = lane & 15, fq = lane >> 4;
      bf16x8 ak[4], aq[4];
#pragma unroll
      for (int ks = 0; ks < 4; ++ks) { ak[ks] = *(const LAS bf16x8*)(kn + (16 * wl + fr) * 136 + 32 * ks + 8 * fq); aq[ks] = *(const LAS bf16x8*)(qn + (16 * wl + fr) * 136 + 32 * ks + 8 * fq); }
      bf16_t* QKs = (bf16_t*)(a.ws + WS_QK) + (size_t)item * 4096;
#pragma unroll
      for (int nt = 0; nt < 4; ++nt) { f32x4 ckk = {0.f, 0.f, 0.f, 0.f}, cqk = {0.f, 0.f, 0.f, 0.f};
#pragma unroll
          for (int ks = 0; ks < 4; ++ks) { const bf16x8 bb = *(const LAS bf16x8*)(kn + (16 * nt + fr) * 136 + 32 * ks + 8 * fq); ckk = MFMA16(ak[ks], bb, ckk); cqk = MFMA16(aq[ks], bb, cqk); }
          const int j = 16 * nt + fr; const float gj = gcs[j]; const int pj = perm6(j);
#pragma unroll
          for (int reg = 0; reg < 4; ++reg) { const int t = 16 * wl + 4 * fq + reg; const float dec = (j <= t) ? __expf(gcs[t] - gj) : 0.f;
              if (j < t) Mm[t * 64 + j] = betas[t] * ckk[reg] * dec;
              QKs[t * 64 + pj] = f2bf(cqk[reg] * dec); } }
      bf16_t* QDs = (bf16_t*)(a.ws + WS_QD) + (size_t)item * 8192;
      for (int e = tl; e < 1024; e += 256) { const int t = e >> 4, grp = e & 15, ks = grp >> 2, f2 = grp & 3; const float eg = egs[t];
          const u32x2 x0 = *(const LAS u32x2*)(qn + t * 136 + 32 * ks + 4 * f2), x1 = *(const LAS u32x2*)(qn + t * 136 + 32 * ks + 16 + 4 * f2);
          u32x4 w; w.x = pk2(bflo(x0.x) * eg, bfhi(x0.x) * eg); w.y = pk2(bflo(x0.y) * eg, bfhi(x0.y) * eg); w.z = pk2(bflo(x1.x) * eg, bfhi(x1.x) * eg); w.w = pk2(bflo(x1.y) * eg, bfhi(x1.y) * eg);
          *(u32x4*)(QDs + t * 128 + 32 * ks + 8 * f2) = w; }
      bf16_t* KETs = (bf16_t*)(a.ws + WS_KET) + (size_t)item * 8192; const float g63 = gcs[63];
      for (int e = tl; e < 1024; e += 256) { const int dk = e & 127, grp = e >> 7, ks = grp >> 2, f2 = grp & 3; float v[8];
#pragma unroll
          for (int i = 0; i < 8; ++i) { const int t = 32 * ks + 16 * (i >> 2) + 4 * f2 + (i & 3); v[i] = bf2f(kn[t * 136 + dk]) * egs[64 + t]; }
          u32x4 w; w.x = pk2(v[0], v[1]); w.y = pk2(v[2], v[3]); w.z = pk2(v[4], v[5]); w.w = pk2(v[6], v[7]);
          *(u32x4*)(KETs + dk * 64 + 32 * ks + 8 * f2) = w; }
    }
    __syncthreads();
    { const int c = tl; const bool isv = c < 128; const LAS bf16_t* colp = isv ? (vv + c) : (kn + (c - 128));
      float* UVs = (float*)(a.ws + WS_UV) + (size_t)item * 8192 + (size_t)(((c >> 4) & 7) * 4 * 64 + (c & 15)) * 4;
      bf16_t* WKs = (bf16_t*)(a.ws + WS_WK) + (size_t)item * 8192 + perm7(c & 127);
      f32x2 xp[32]; f32x4 mA[8], mB[8];
      SolveCtx sc_{Mm, betas, egs, colp, UVs, WKs, isv};
      mA[0] = *(const LAS f32x4*)(Mm + 64);
      { float sc = betas[0]; if (!isv) sc *= egs[0]; const float x0 = sc * bf2f(colp[0]); xp[0][0] = x0; if (!isv) WKs[0] = f2bf(x0); }
      solve_row<1>(sc_, xp, mA, mB, betas[1], egs[1], colp[136]);
    }
    __syncthreads();
}

DI void sample_item(LAS unsigned char* lds, const Args& a, int l, int item) {
    int tid_ = threadIdx.x; asm volatile("" : "+v"(tid_));
    const int tid = tid_, h = item & 3, b = item >> 2, row = NPROMPT + b;
    LAS float* vals = (LAS float*)lds;
    LAS float* red3 = vals + 384;
    LAS float* red = vals + 512;
    const bf16_t* PROJ = (const bf16_t*)(a.ws + WS_HID);
    float myv = 0.f;
    if (tid < 384) { const int sec = tid >> 7, c = tid & 127, col = sec * 512 + h * 128 + c;
        const float x0 = bf2f(PROJ[(size_t)row * NPROJ + col]);
        const float* sc = INP(a, 3) + (size_t)(l * 128 + b) * 3 * QKVD + col; const float* cw = INP(a, 11) + (size_t)l * 4 * QKVD + col;
        myv = silu_f(cw[0] * sc[0] + cw[QKVD] * sc[QKVD] + cw[2 * QKVD] * sc[2 * QKVD] + cw[3 * QKVD] * x0);
        vals[tid] = myv; }
    __syncthreads();
    if (tid < 192) { const int w = tid >> 6, lane = tid & 63; float s;
        if (w == 0) s = vals[lane] * vals[lane] + vals[lane + 64] * vals[lane + 64];
        else if (w == 1) s = vals[128 + lane] * vals[128 + lane] + vals[192 + lane] * vals[192 + lane];
        else s = vals[lane] * vals[128 + lane] + vals[lane + 64] * vals[192 + lane];
        s = wave_sum(s); if (lane == 0) red3[w] = s; }
    __syncthreads();
    const float qsc = rsqrtf(red3[0] + 1e-6f) * 0.08838834764831845f, ksc = rsqrtf(red3[1] + 1e-6f), qkdot = red3[2] * qsc * ksc;
    const float beta = ((const float*)(a.ws + WS_BETA))[(size_t)row * 4 + h], ga = expf(((const float*)(a.ws + WS_G))[(size_t)row * 4 + h]);
    const int dv4 = tid & 31, dkg = tid >> 5;
    const float* S0 = INP(a, 2) + (size_t)((l * 128 + b) * 4 + h) * 16384;
    f32x4 S[8]; f32x4 ks4 = {0.f, 0.f, 0.f, 0.f}, qs4 = {0.f, 0.f, 0.f, 0.f};
#pragma unroll
    for (int j = 0; j < 8; ++j) { const int dk = dkg * 8 + j; S[j] = __builtin_nontemporal_load((const f32x4*)(S0 + dk * 128 + dv4 * 4)); const float kk = vals[128 + dk] * ksc, qq = vals[dk] * qsc; ks4 += S[j] * kk; qs4 += S[j] * qq; }
    *(LAS f32x4*)(red + (dkg * 128 + dv4 * 4) * 2) = ks4; *(LAS f32x4*)(red + (dkg * 128 + dv4 * 4) * 2 + 4) = qs4;
    __syncthreads();
    f32x4 kS = {0.f, 0.f, 0.f, 0.f}, qS = {0.f, 0.f, 0.f, 0.f};
#pragma unroll
    for (int g = 0; g < 16; ++g) { kS += *(const LAS f32x4*)(red + (g * 128 + dv4 * 4) * 2); qS += *(const LAS f32x4*)(red + (g * 128 + dv4 * 4) * 2 + 4); }
    f32x4 v4 = *(const LAS f32x4*)(vals + 256 + dv4 * 4);
    const f32x4 u = v4 * beta - kS * (beta * ga);
    float* Sout = a.out + OUT_DS + (size_t)((l * 128 + b) * 4 + h) * 16384;
#pragma unroll
    for (int j = 0; j < 8; ++j) { const int dk = dkg * 8 + j; const float kk = vals[128 + dk] * ksc; __builtin_nontemporal_store(S[j] * ga + u * kk, (f32x4*)(Sout + dk * 128 + dv4 * 4)); }
    if (dkg == 0) { const f32x4 o = qS * ga + u * qkdot; *(f32x4*)((float*)(a.ws + WS_O) + (size_t)row * 512 + h * 128 + dv4 * 4) = o; }
    __syncthreads();
}

template <int W>
DI void pool_fill(LAS bf16_t* dA, const Args& a, int l, int g, int t0, int tid) {
    const bf16_t* PROJ = (const bf16_t*)(a.ws + WS_HID);
    const int c0 = (tid & 31) * 4, rg = tid >> 5, lr0 = rg * 8, row0 = t0 + lr0;
    if (t0 < NPROMPT) {
        const int tpos0 = row0 & 2047;
        const bf16_t* pp = PROJ + (size_t)row0 * NPROJ + 2048 + g * 128 + c0;
        f32x4 pv[W + 7];
#pragma unroll
        for (int i = 0; i < W + 7; ++i) { const int dr = i - (W - 1);
            if (tpos0 + dr >= 0) { const u32x2 rw = *(const u32x2*)(pp + (long)dr * NPROJ); pv[i] = (f32x4){bflo(rw.x), bfhi(rw.x), bflo(rw.y), bfhi(rw.y)}; }
            else pv[i] = (f32x4){0.f, 0.f, 0.f, 0.f}; }
#pragma unroll
        for (int j = 0; j < 8; ++j) { f32x4 sum = pv[j];
#pragma unroll
            for (int i = 1; i < W; ++i) sum += pv[j + i];
            const int tp = tpos0 + j; const float inv = __builtin_amdgcn_rcpf((float)((tp + 1 < W) ? tp + 1 : W));
            const f32x4 d = sum * inv - pv[j + W - 1]; u32x2 pw; pw.x = pk2(d[0], d[1]); pw.y = pk2(d[2], d[3]); *(LAS u32x2*)(dA + (lr0 + j) * 136 + c0) = pw; }
    } else {
#pragma unroll
        for (int j = 0; j < 8; ++j) { const int row = row0 + j; const bf16_t* pp = PROJ + (size_t)row * NPROJ + 2048 + g * 128 + c0;
            const u32x2 raw = *(const u32x2*)pp; const f32x4 p0 = {bflo(raw.x), bfhi(raw.x), bflo(raw.y), bfhi(raw.y)}; f32x4 sum = p0;
            const float* sp = INP(a, 4) + (size_t)(l * 128 + (row - NPROMPT)) * 15 * 512 + g * 128 + c0;
#pragma unroll
            for (int i = 1; i < W; ++i) sum += *(const f32x4*)(sp + (size_t)(15 - i) * 512);
            const f32x4 d = sum * (1.f / (float)W) - p0; u32x2 pw; pw.x = pk2(d[0], d[1]); pw.y = pk2(d[2], d[3]); *(LAS u32x2*)(dA + (lr0 + j) * 136 + c0) = pw; }
    }
}
DI void pool_item(LAS unsigned char* lds, const Args& a, int l, int item) {
    int tid_ = threadIdx.x; asm volatile("" : "+v"(tid_));
    const int tid = tid_, g = item & 3, rt = item >> 2, t0 = rt * 128;
    LAS bf16_t* dA = (LAS bf16_t*)lds; LAS bf16_t* wB = dA + 128 * 136;
    const bf16_t* PW = (const bf16_t*)(a.ws + WS_W + (size_t)l * W_LSTRIDE + WO_PW) + (size_t)g * 16384;
    for (int e = tid; e < 2048; e += 512) { const int r = e >> 4, c8 = (e & 15) * 8; *(LAS u32x4*)(wB + r * 136 + c8) = *(const u32x4*)(PW + r * 128 + c8); }
    if (g == 0) pool_fill<2>(dA, a, l, g, t0, tid); else if (g == 1) pool_fill<4>(dA, a, l, g, t0, tid); else if (g == 2) pool_fill<8>(dA, a, l, g, t0, tid); else pool_fill<16>(dA, a, l, g, t0, tid);
    __syncthreads();
    { const int w8 = tid >> 6, lane = tid & 63, fr = lane & 15, fq = lane >> 4;
      bf16x8 af[4];
#pragma unroll
      for (int ks = 0; ks < 4; ++ks) af[ks] = *(const LAS bf16x8*)(dA + (16 * w8 + fr) * 136 + 32 * ks + 8 * fq);
      bf16_t* MIX = (bf16_t*)(a.ws + WS_MIX); const float* psc = INP(a, 16) + l * 512 + g * 128;
#pragma unroll
      for (int nt = 0; nt < 8; ++nt) { f32x4 acc = {0.f, 0.f, 0.f, 0.f};
#pragma unroll
          for (int ks = 0; ks < 4; ++ks) { const bf16x8 bb = *(const LAS bf16x8*)(wB + (16 * nt + fr) * 136 + 32 * ks + 8 * fq); acc = MFMA16(af[ks], bb, acc); }
          const int col = 16 * nt + fr; const float sc = psc[col];
#pragma unroll
          for (int reg = 0; reg < 4; ++reg) MIX[(size_t)(t0 + 16 * w8 + 4 * fq + reg) * DM + 512 + g * 128 + col] = f2bf(acc[reg] * sc); } }
    __syncthreads();
}

DI void scan_phase(LAS unsigned char* lds, const Args& a, int l) {
    int tid_ = threadIdx.x; asm volatile("" : "+v"(tid_));
    const int tid = tid_, s = tid >> 6, lane = tid & 63, fr = lane & 15, fq = lane >> 4;
    constexpr int BUF = 62464, O_WK = 0, O_QD = 17408, O_KET = 34816, O_QK = 53248;
    const int lw0 = (tid >> 4) * 272 + (tid & 15) * 16, lw1 = ((tid + 512) >> 4) * 272 + (tid & 15) * 16;
    const int lk0 = (tid >> 3) * 144 + (tid & 7) * 16, lk1 = ((tid + 512) >> 3) * 144 + (tid & 7) * 16;
#define SC_LOADG(it_) do { const unsigned char* _w = a.ws + WS_WK + (size_t)(it_) * 16384 + tid * 16; const unsigned char* _q = a.ws + WS_QD + (size_t)(it_) * 16384 + tid * 16; \
        const unsigned char* _k = a.ws + WS_KET + (size_t)(it_) * 16384 + tid * 16; \
        pf[0] = *(const u32x4*)_w; pf[1] = *(const u32x4*)(_w + 8192); pf[2] = *(const u32x4*)_q; pf[3] = *(const u32x4*)(_q + 8192); \
        pf[4] = *(const u32x4*)_k; pf[5] = *(const u32x4*)(_k + 8192); pf[6] = *(const u32x4*)(a.ws + WS_QK + (size_t)(it_) * 8192 + tid * 16); \
        } while (0)
#define SC_LOADUV(it_) do { const float* _u = (const float*)(a.ws + WS_UV) + (size_t)(it_) * 8192 + s * 1024 + lane * 4; \
        uvn[0] = *(const f32x4*)_u; uvn[1] = *(const f32x4*)(_u + 256); uvn[2] = *(const f32x4*)(_u + 512); uvn[3] = *(const f32x4*)(_u + 768); \
        gen = ((const float*)(a.ws + WS_GE))[(it_)]; } while (0)
#define SC_STORE(bo_) do { LAS unsigned char* _b = lds + (bo_); \
        *(LAS u32x4*)(_b + O_WK + lw0) = pf[0]; *(LAS u32x4*)(_b + O_WK + lw1) = pf[1]; *(LAS u32x4*)(_b + O_QD + lw0) = pf[2]; *(LAS u32x4*)(_b + O_QD + lw1) = pf[3]; \
        *(LAS u32x4*)(_b + O_KET + lk0) = pf[4]; *(LAS u32x4*)(_b + O_KET + lk1) = pf[5]; *(LAS u32x4*)(_b + O_QK + lk0) = pf[6]; } while (0)
    for (int bh = blockIdx.x; bh < 32; bh += gridDim.x) {
        const int b = bh >> 2, h = bh & 3;
        const size_t item0 = (size_t)bh * 32;
        f32x4 S[8]; bf16x8 Sb[4];
#pragma unroll
        for (int i = 0; i < 8; ++i) S[i] = (f32x4){0.f, 0.f, 0.f, 0.f};
#pragma unroll
        for (int i = 0; i < 4; ++i) Sb[i] = (bf16x8){0, 0, 0, 0, 0, 0, 0, 0};
        u32x4 pf[7]; f32x4 uvn[4], uvc[4]; float gen, gec;
        SC_LOADG(item0); SC_LOADUV(item0);
        SC_STORE(0);
#pragma unroll
        for (int m = 0; m < 4; ++m) uvc[m] = uvn[m];
        gec = gen;
        SC_LOADG(item0 + 1);
        __syncthreads();
        float* O = (float*)(a.ws + WS_O);
        for (int n = 0; n < 32; ++n) {
            const int cur = (n & 1) * BUF;
            if (n + 1 < 32) { SC_STORE(BUF - cur); SC_LOADUV(item0 + n + 1); }
            if (n + 2 < 32) SC_LOADG(item0 + n + 2);
            const LAS unsigned char* B = lds + cur;
            f32x4 ws[4], o[4];
#pragma unroll
            for (int m = 0; m < 4; ++m) { ws[m] = (f32x4){0.f, 0.f, 0.f, 0.f}; o[m] = (f32x4){0.f, 0.f, 0.f, 0.f}; }
#pragma unroll
            for (int ks = 0; ks < 4; ++ks)
#pragma unroll
                for (int m = 0; m < 4; ++m) { const bf16x8 av = *(const LAS bf16x8*)(B + O_WK + (16 * m + fr) * 272 + (32 * ks + 8 * fq) * 2); ws[m] = MFMA16(av, Sb[ks], ws[m]); }
#pragma unroll
            for (int ks = 0; ks < 4; ++ks)
#pragma unroll
                for (int m = 0; m < 4; ++m) { const bf16x8 av = *(const LAS bf16x8*)(B + O_QD + (16 * m + fr) * 272 + (32 * ks + 8 * fq) * 2); o[m] = MFMA16(av, Sb[ks], o[m]); }
            f32x4 u[4];
#pragma unroll
            for (int m = 0; m < 4; ++m) u[m] = uvc[m] - ws[m];
            bf16x8 Ub[2]; Ub[0] = pack8(u[0], u[1]); Ub[1] = pack8(u[2], u[3]);
#pragma unroll
            for (int ks = 0; ks < 2; ++ks)
#pragma unroll
                for (int m = 0; m < 4; ++m) { const bf16x8 av = *(const LAS bf16x8*)(B + O_QK + (16 * m + fr) * 144 + (32 * ks + 8 * fq) * 2); o[m] = MFMA16(av, Ub[ks], o[m]); }
#pragma unroll
            for (int mt = 0; mt < 8; ++mt) S[mt] = S[mt] * gec;
#pragma unroll
            for (int ks = 0; ks < 2; ++ks)
#pragma unroll
                for (int mt = 0; mt < 8; ++mt) { const bf16x8 av = *(const LAS bf16x8*)(B + O_KET + (16 * mt + fr) * 144 + (32 * ks + 8 * fq) * 2); S[mt] = MFMA16(av, Ub[ks], S[mt]); }
#pragma unroll
            for (int ks = 0; ks < 4; ++ks) Sb[ks] = pack8(S[2 * ks], S[2 * ks + 1]);
            float* op = O + (size_t)(b * 2048 + n * 64 + 4 * fq) * 512 + h * 128 + 16 * s + fr;
#pragma unroll
            for (int m = 0; m < 4; ++m)
#pragma unroll
                for (int reg = 0; reg < 4; ++reg) op[(size_t)(16 * m + reg) * 512] = o[m][reg];
#pragma unroll
            for (int m = 0; m < 4; ++m) uvc[m] = uvn[m];
            gec = gen;
            __syncthreads();
        }
        float* dp = a.out + OUT_DP + (size_t)((l * 8 + b) * 4 + h) * 16384 + (size_t)(4 * fq) * 128 + 16 * s + fr;
#pragma unroll
        for (int mt = 0; mt < 8; ++mt)
#pragma unroll
            for (int reg = 0; reg < 4; ++reg) __builtin_nontemporal_store(S[mt][reg], dp + (size_t)(16 * mt + reg) * 128);
    }
#undef SC_LOADG
#undef SC_LOADUV
#undef SC_STORE
}

DI void gate_phase(const Args& a, int l) {
    int tid_ = threadIdx.x; asm volatile("" : "+v"(tid_));
    const int tid = tid_, wave = tid >> 6, lane = tid & 63;
    const float* O = (const float*)(a.ws + WS_O); const bf16_t* PROJ = (const bf16_t*)(a.ws + WS_HID); bf16_t* MIX = (bf16_t*)(a.ws + WS_MIX);
    const float* og = INP(a, 14) + l * 128 + (lane & 15) * 8;
    const f32x4 g0 = *(const f32x4*)og, g1 = *(const f32x4*)(og + 4);
    f32x4 n0 = {0.f, 0.f, 0.f, 0.f}, n1 = {0.f, 0.f, 0.f, 0.f}; u32x4 nz = {0u, 0u, 0u, 0u};
    { const int row = blockIdx.x * 8 + wave; if (row < NVALID) { n0 = *(const f32x4*)(O + (size_t)row * 512 + lane * 8); n1 = *(const f32x4*)(O + (size_t)row * 512 + lane * 8 + 4); nz = *(const u32x4*)(PROJ + (size_t)row * NPROJ + 1536 + lane * 8); } }
    for (int row = blockIdx.x * 8 + wave; row < NVALID; row += gridDim.x * 8) {
        const f32x4 o0 = n0, o1 = n1; const u32x4 zr = nz;
        { const int nrow = row + gridDim.x * 8; if (nrow < NVALID) { n0 = *(const f32x4*)(O + (size_t)nrow * 512 + lane * 8); n1 = *(const f32x4*)(O + (size_t)nrow * 512 + lane * 8 + 4); nz = *(const u32x4*)(PROJ + (size_t)nrow * NPROJ + 1536 + lane * 8); } }
        float ss = (o0[0] * o0[0] + o0[1] * o0[1]) + (o0[2] * o0[2] + o0[3] * o0[3]) + (o1[0] * o1[0] + o1[1] * o1[1]) + (o1[2] * o1[2] + o1[3] * o1[3]);
        ss += __shfl_xor(ss, 8); ss += __shfl_xor(ss, 4); ss += __shfl_xor(ss, 2); ss += __shfl_xor(ss, 1);
        const float rs = rsqrtf(ss * (1.f / 128.f) + 1e-6f);
        float r[8];
        r[0] = o0[0] * rs * g0[0] * silu_f(bflo(zr.x)); r[1] = o0[1] * rs * g0[1] * silu_f(bfhi(zr.x));
        r[2] = o0[2] * rs * g0[2] * silu_f(bflo(zr.y)); r[3] = o0[3] * rs * g0[3] * silu_f(bfhi(zr.y));
        r[4] = o1[0] * rs * g1[0] * silu_f(bflo(zr.z)); r[5] = o1[1] * rs * g1[1] * silu_f(bfhi(zr.z));
        r[6] = o1[2] * rs * g1[2] * silu_f(bflo(zr.w)); r[7] = o1[3] * rs * g1[3] * silu_f(bfhi(zr.w));
        u32x4 wv; wv.x = pk2(r[0], r[1]); wv.y = pk2(r[2], r[3]); wv.z = pk2(r[4], r[5]); wv.w = pk2(r[6], r[7]);
        *(u32x4*)(MIX + (size_t)row * DM + lane * 8) = wv;
    }
}

__global__ void __launch_bounds__(512) mk_fwd(Args a) {
    extern __shared__ __attribute__((aligned(16))) unsigned char lds_raw[];
    LAS unsigned char* lds = (LAS unsigned char*)lds_raw;
    cg::grid_group grid = cg::this_grid();
    const int G = gridDim.x;
    volatile LAS unsigned* xst = (volatile LAS unsigned*)(lds + LDS_MAIN);
    if (threadIdx.x < 4) xst[threadIdx.x] = 0u;
    __syncthreads();
    (void)xcd_barrier_post((unsigned*)(a.ws + WS_BAR), xst);
    for (int ph = a.ph_lo; ph < a.ph_hi; ++ph) {
        if (ph > a.ph_lo) { if (ph == 1) grid.sync(); else { XcdBarrier xbar; xbar.bar = (unsigned*)(a.ws + WS_BAR); xbar.x = xb_xcc_id(); xbar.st = (volatile LAS unsigned*)(lds + LDS_MAIN); xcd_barrier(xbar); } }
        if (ph == 0) { if (PHON(0)) prep_phase(lds, a); continue; }
        const int l = (ph - 1) / 12, k = (ph - 1) % 12;
        const unsigned char* Wl = a.ws + WS_W + (size_t)l * W_LSTRIDE;
        if (PHON(1) && (k == 0 || k == 9)) {
            pg8::Gemm g{(const bf16_t*)(a.ws + WS_XB), (const bf16_t*)(Wl + (k == 0 ? WO_GU1 : WO_GU2)), ROWS, 5632, DM};
            pg8::StaticOrder S; S.init(ROWS, 5632, DM, G, (int)blockIdx.x, 0);
            EpiSwiglu E{(bf16_t*)(a.ws + WS_HID)};
            pg8::gemm_phase<EpiSwiglu, pg8::StaticOrder>(lds, g, S, E);
        } else if (PHON(2) && (k == 1 || k == 10 || k == 7)) {
            pg8::Gemm g{(const bf16_t*)(a.ws + (k == 7 ? WS_MIX : WS_HID)), (const bf16_t*)(Wl + (k == 1 ? WO_D1 : (k == 10 ? WO_D2 : WO_WOUT))), ROWS, DM, k == 7 ? DM : FF};
            pg8::StaticOrder S; S.init(NPROMPT, DM, k == 7 ? DM : FF, G, (int)blockIdx.x, k == 7 ? 4 : 11);
            EpiResid E{(float*)(a.ws + WS_R), (float*)(a.ws + WS_PART), k == 7 ? 1.0f : 0.5f};
            pg8::gemm_phase<EpiResid, pg8::StaticOrder>(lds, g, S, E);
        } else if (PHON(3) && (k == 2 || k == 8 || k == 11)) {
            ln_phase(lds, a, l, k == 2 ? 1 : (k == 8 ? 2 : 3));
        } else if (PHON(4) && k == 3) {
            pg8::Gemm g{(const bf16_t*)(a.ws + WS_XB), (const bf16_t*)(Wl + WO_WIN), ROWS, NPROJ, DM};
            pg8::StaticOrder S; S.init(ROWS, NPROJ, DM, G, (int)blockIdx.x, 0);
            EpiProj E{(bf16_t*)(a.ws + WS_HID), a.out, l};
            pg8::gemm_phase<EpiProj, pg8::StaticOrder>(lds, g, S, E);
        } else if (k == 4) {
            for (int it = blockIdx.x; it < 512; it += G) {
                if (PHON(5)) { int tq = threadIdx.x; asm volatile("" : "+v"(tq)); const int hb = tq >> 8; dprep_item(lds + hb * 69632, a, l, it * 2 + hb, tq & 255); }
            }
        } else if (PHON(8) && k == 5) {
            if ((int)blockIdx.x < 32 || G <= 32) scan_phase(lds, a, l);
            if (G <= 32) __syncthreads();
            if ((int)blockIdx.x >= 32 || G <= 32) {
                const int nb = (G > 32) ? G - 32 : G, b0 = (G > 32) ? (int)blockIdx.x - 32 : (int)blockIdx.x;
                for (int it = b0; it < 512 + 516; it += nb) {
                    if (PHON(6) && it < 512) sample_item(lds, a, l, it);
                    else if (PHON(7) && it >= 512) pool_item(lds, a, l, it - 512);
                }
            }
        } else if (PHON(9) && k == 6) {
            gate_phase(a, l);
        }
    }
}

extern "C" void kernel_launch(void* const* d_in, const int* in_sizes, int n_in, void* d_out, int out_size, void* d_ws, size_t ws_size, hipStream_t stream) {
    static int grid = 0;
    if (grid == 0) {
        if (n_in != 25 || ws_size < WS_END) { fprintf(stderr, "kernel_launch: need 25 inputs and >= %zu bytes of workspace; got %d, %zu\n", (size_t)WS_END, n_in, ws_size); grid = -1; return; }
        int dev = 0, cus = 0, per_cu = 0;
        hipGetDevice(&dev); hipDeviceGetAttribute(&cus, hipDeviceAttributeMultiprocessorCount, dev);
        if (hipFuncSetAttribute((const void*)mk_fwd, hipFuncAttributeMaxDynamicSharedMemorySize, LDS_BYTES) != hipSuccess) { fprintf(stderr, "kernel_launch: hipFuncSetAttribute failed\n"); grid = -1; return; }
        if (hipOccupancyMaxActiveBlocksPerMultiprocessor(&per_cu, (const void*)mk_fwd, 512, LDS_BYTES) != hipSuccess || per_cu < 1) { fprintf(stderr, "kernel_launch: occupancy query gave %d\n", per_cu); per_cu = 1; }
        (void)hipGetLastError();
        grid = cus * 1;
        if (grid <= 0) grid = 256;
    }
    if (grid < 0) return;
    Args a{};
    for (int i = 0; i < 25; ++i) a.in[i] = (const float*)d_in[i];
    a.out = (float*)d_out; a.ws = (unsigned char*)d_ws;
#if MK_MULTI
    for (int ph = 0; ph < NPH; ++ph) { a.ph_lo = ph; a.ph_hi = ph + 1; hipLaunchKernelGGL(mk_fwd, dim3(grid), dim3(512), LDS_BYTES, stream, a); }
#else
    a.ph_lo = 0; a.ph_hi = NPH;
    if (hipMemsetAsync((char*)d_ws + WS_BAR, 0, 16384, stream) != hipSuccess) { fprintf(stderr, "kernel_launch: memset of barrier words failed\n"); return; }
    void* args[] = {&a};
    hipError_t e = hipLaunchCooperativeKernel((const void*)mk_fwd, dim3(grid), dim3(512), args, LDS_BYTES, stream);
    if (e != hipSuccess) fprintf(stderr, "cooperative launch failed: %s (grid %d)\n", hipGetErrorString(e), grid);
#endif
}
```
